# Optimizing an MI355X kernel written in HIP

```python
import math
import jax, jax.numpy as jnp
from jax import lax
import numpy as np

D_MODEL = 1024
BATCH = 16
SEQ = 2048
DEPTH = 2

RET_HEADS = 4
RET_HEAD_DIM = 128
ATT_HEADS = 4
ATT_HEAD_DIM = 128
IDX_HEADS = 8
IDX_DIM = 64
RET_WIDTH = RET_HEADS * RET_HEAD_DIM
ATT_WIDTH = ATT_HEADS * ATT_HEAD_DIM
MIX_WIDTH = RET_WIDTH + ATT_WIDTH
FFN_HIDDEN = -(-(8 * D_MODEL) // (3 * 256)) * 256
TOPK_MAX = 256
ROPE_THETA = 10000.0
RET_CHUNK = 128
IDX_BLOCK = 128
ATT_BLOCK = 32
LN_EPS = 1e-5
DEEPNORM_ALPHA = (2.0 * DEPTH) ** 0.25
DEEPNORM_BETA = (8.0 * DEPTH) ** -0.25

IN_SIZES = (RET_WIDTH, RET_WIDTH, RET_WIDTH, RET_WIDTH,
            ATT_WIDTH, ATT_WIDTH, ATT_WIDTH,
            IDX_HEADS * IDX_DIM, IDX_DIM, IDX_HEADS)
IN_COLS = sum(IN_SIZES)
IN_SPLITS = tuple(int(s) for s in np.cumsum(IN_SIZES)[:-1])

kernel_name = "hybrid_retention_dsa_deepnorm"


def rope(x, positions):
    d = x.shape[-1]
    inv_freq = ROPE_THETA ** (-jnp.arange(0, d, 2, dtype=jnp.float32) / d)
    ang = positions.astype(jnp.float32)[..., None] * inv_freq
    cos = jnp.cos(ang)[:, :, None, :].astype(x.dtype)
    sin = jnp.sin(ang)[:, :, None, :].astype(x.dtype)
    x1, x2 = x[..., : d // 2], x[..., d // 2:]
    return jnp.concatenate([x1 * cos - x2 * sin, x1 * sin + x2 * cos], axis=-1)


def layer_norm(x, g, b):
    xf = x.astype(jnp.float32)
    mu = jnp.mean(xf, axis=-1, keepdims=True)
    var = jnp.mean(jnp.square(xf - mu), axis=-1, keepdims=True)
    y = (xf - mu) * lax.rsqrt(var + LN_EPS)
    return (y * g.astype(jnp.float32) + b.astype(jnp.float32)).astype(x.dtype)


def retention_chunkwise(q, k, v):
    B, S, H, d = q.shape
    C = RET_CHUNK
    N = S // C
    log_g = jnp.log(1.0 - 2.0 ** (-5.0 - jnp.arange(H, dtype=jnp.float32)))
    pos = jnp.arange(C, dtype=jnp.float32)
    rel = pos[:, None] - pos[None, :]
    decay_intra = jnp.where(rel >= 0,
                            jnp.exp(log_g[:, None, None] * jnp.maximum(rel, 0.0)),
                            0.0)
    decay_q = jnp.exp(log_g[:, None] * (pos + 1.0))
    decay_k = jnp.exp(log_g[:, None] * (C - 1.0 - pos))
    decay_chunk = jnp.exp(log_g * C)

    def to_chunks(t):
        return t.astype(jnp.float32).reshape(B, N, C, H, d).transpose(1, 0, 3, 2, 4)

    qc, kc, vc = to_chunks(q), to_chunks(k) * (d ** -0.5), to_chunks(v)
    scores = jnp.einsum('nbhid,nbhjd->nbhij', qc, kc) * decay_intra
    inner = jnp.einsum('nbhij,nbhjd->nbhid', scores, vc)
    kv = jnp.einsum('nbhjd,nbhje->nbhde', kc * decay_k[:, :, None], vc)

    def step(state, kv_n):
        return decay_chunk[:, None, None] * state + kv_n, state

    _, prev = lax.scan(step, jnp.zeros((B, H, d, d), jnp.float32), kv)
    cross = jnp.einsum('nbhid,nbhde->nbhie', qc, prev) * decay_q[:, :, None]
    out = inner + cross
    return out.transpose(1, 0, 3, 2, 4).reshape(B, S, H, d)


def indexer_topk(q_idx, k_idx, w_idx, topk):
    B, S, HI, DI = q_idx.shape
    nblk = S // IDX_BLOCK
    qf = q_idx.astype(jnp.float32) * (DI ** -0.5)
    kf = k_idx.astype(jnp.float32)
    wf = w_idx.astype(jnp.float32) * (HI ** -0.5)
    key_pos = jnp.arange(S)
    q_blocks = qf.reshape(B, nblk, IDX_BLOCK, HI, DI).swapaxes(0, 1)
    w_blocks = wf.reshape(B, nblk, IDX_BLOCK, HI).swapaxes(0, 1)
    q_pos = jnp.arange(S).reshape(nblk, IDX_BLOCK)

    def block(args):
        qb, wb, pb = args
        logits = jax.nn.relu(jnp.einsum('bqhd,bsd->bqhs', qb, kf))
        score = jnp.einsum('bqh,bqhs->bqs', wb, logits)
        score = jnp.where(key_pos[None, None, :] <= pb[None, :, None], score, -jnp.inf)
        _, sel = lax.top_k(score, topk)
        return sel.astype(jnp.int32)

    sel = lax.map(block, (q_blocks, w_blocks, q_pos))
    return sel.swapaxes(0, 1).reshape(B, S, topk)


def sparse_attention(q, k, v, sel):
    B, S, H, dh = q.shape
    K = sel.shape[-1]
    nblk = S // ATT_BLOCK
    q_blocks = q.reshape(B, nblk, ATT_BLOCK, H, dh).swapaxes(0, 1)
    s_blocks = sel.reshape(B, nblk, ATT_BLOCK, K).swapaxes(0, 1)
    q_pos = jnp.arange(S).reshape(nblk, ATT_BLOCK)
    gather = jax.vmap(lambda t, i: t[i])

    def block(args):
        qb, sb, pb = args
        kb = gather(k, sb)
        vb = gather(v, sb)
        s = jnp.einsum('bqhd,bqkhd->bhqk', qb, kb).astype(jnp.float32) * (dh ** -0.5)
        valid = sb <= pb[None, :, None]
        s = jnp.where(valid[:, None, :, :], s, -jnp.inf)
        p = jax.nn.softmax(s, axis=-1).astype(vb.dtype)
        return jnp.einsum('bhqk,bqkhd->bqhd', p, vb)

    out = lax.map(block, (q_blocks, s_blocks, q_pos))
    return out.swapaxes(0, 1).reshape(B, S, H, dh)


def hybrid_layer(x, positions, w_in, ret_gn_gain, w_out, ln_mix_gain, ln_mix_bias,
                 w_gate_up, w_down, ln_ffn_gain, ln_ffn_bias):
    B, S, _ = x.shape
    topk = min(TOPK_MAX, S // 4)
    proj = x @ w_in
    rq, rk, rv, rg, aq, ak, av, iq, ik, iw = jnp.split(proj, IN_SPLITS, axis=-1)

    rq = rope(rq.reshape(B, S, RET_HEADS, RET_HEAD_DIM), positions)
    rk = rope(rk.reshape(B, S, RET_HEADS, RET_HEAD_DIM), positions)
    rv = rv.reshape(B, S, RET_HEADS, RET_HEAD_DIM)
    ret = retention_chunkwise(rq, rk, rv)
    mu = jnp.mean(ret, axis=-1, keepdims=True)
    var = jnp.mean(jnp.square(ret - mu), axis=-1, keepdims=True)
    ret = ((ret - mu) * lax.rsqrt(var + LN_EPS)).reshape(B, S, RET_WIDTH)
    ret = (ret * ret_gn_gain.astype(jnp.float32)).astype(x.dtype)
    ret = jax.nn.silu(rg) * ret

    aq = rope(aq.reshape(B, S, ATT_HEADS, ATT_HEAD_DIM), positions)
    ak = rope(ak.reshape(B, S, ATT_HEADS, ATT_HEAD_DIM), positions)
    av = av.reshape(B, S, ATT_HEADS, ATT_HEAD_DIM)
    iq = rope(iq.reshape(B, S, IDX_HEADS, IDX_DIM), positions)
    ik = rope(ik[:, :, None, :], positions)[:, :, 0, :]
    sel = indexer_topk(iq, ik, iw, topk)
    att = sparse_attention(aq, ak, av, sel).reshape(B, S, ATT_WIDTH)

    mix = jnp.concatenate([ret, att], axis=-1) @ w_out
    x = layer_norm(DEEPNORM_ALPHA * x + mix, ln_mix_gain, ln_mix_bias)

    gate, up = jnp.split(x @ w_gate_up, 2, axis=-1)
    ffn = (jax.nn.silu(gate) * up) @ w_down
    return layer_norm(DEEPNORM_ALPHA * x + ffn, ln_ffn_gain, ln_ffn_bias)


def setup_inputs(seed: int = 0) -> dict:
    key = jax.random.key(seed)
    ks = jax.random.split(key, 12)
    f32 = jnp.float32
    x = jax.random.normal(ks[0], (BATCH, SEQ, D_MODEL), f32)
    start = jax.random.randint(ks[1], (BATCH, 1), 0, 4096, dtype=jnp.int32)
    positions = (start + jnp.arange(SEQ, dtype=jnp.int32)[None, :]).astype(jnp.int32)
    w_in = jax.random.normal(ks[2], (DEPTH, D_MODEL, IN_COLS), f32) * D_MODEL ** -0.5
    ret_gn_gain = 1.0 + 0.02 * jax.random.normal(ks[3], (DEPTH, RET_WIDTH), f32)
    w_out = jax.random.normal(ks[4], (DEPTH, MIX_WIDTH, D_MODEL), f32) * (MIX_WIDTH ** -0.5 * DEEPNORM_BETA)
    ln_mix_gain = 1.0 + 0.02 * jax.random.normal(ks[5], (DEPTH, D_MODEL), f32)
    ln_mix_bias = 0.02 * jax.random.normal(ks[6], (DEPTH, D_MODEL), f32)
    w_gate_up = jax.random.normal(ks[7], (DEPTH, D_MODEL, 2 * FFN_HIDDEN), f32) * D_MODEL ** -0.5
    w_down = jax.random.normal(ks[8], (DEPTH, FFN_HIDDEN, D_MODEL), f32) * (FFN_HIDDEN ** -0.5 * DEEPNORM_BETA)
    ln_ffn_gain = 1.0 + 0.02 * jax.random.normal(ks[9], (DEPTH, D_MODEL), f32)
    ln_ffn_bias = 0.02 * jax.random.normal(ks[10], (DEPTH, D_MODEL), f32)
    return {"x": x, "positions": positions, "w_in": w_in, "ret_gn_gain": ret_gn_gain,
            "w_out": w_out, "ln_mix_gain": ln_mix_gain, "ln_mix_bias": ln_mix_bias,
            "w_gate_up": w_gate_up, "w_down": w_down,
            "ln_ffn_gain": ln_ffn_gain, "ln_ffn_bias": ln_ffn_bias}


def reference(x, positions, w_in, ret_gn_gain, w_out, ln_mix_gain, ln_mix_bias,
              w_gate_up, w_down, ln_ffn_gain, ln_ffn_bias):
    for layer in range(DEPTH):
        x = hybrid_layer(x, positions, w_in[layer], ret_gn_gain[layer], w_out[layer],
                         ln_mix_gain[layer], ln_mix_bias[layer], w_gate_up[layer],
                         w_down[layer], ln_ffn_gain[layer], ln_ffn_bias[layer])
    return x
```

```cpp
#include <hip/hip_runtime.h>
#include <hip/hip_cooperative_groups.h>
#include <cstdio>
#include <cstdint>
namespace cg = cooperative_groups;
__device__ __forceinline__ int opaque_tid() { int t = threadIdx.x; asm volatile("" : "+v"(t)); return t; }

namespace pg8 {
#define PG8_LAS __attribute__((address_space(3)))
typedef unsigned short bf16_t;
typedef short bf16x8 __attribute__((ext_vector_type(8)));
typedef float f32x4 __attribute__((ext_vector_type(4)));
typedef unsigned u32x4 __attribute__((ext_vector_type(4)));
constexpr int BM = 256, BK = 64, HALF = 128, HTB = HALF * BK * 2  , STAGE_BYTES = 8 * HTB, NXCD = 8, WGM = 8;

__host__ __device__ __forceinline__ int lds_byte(int r, int c) { const int st = (r >> 4) * 2 + (c >> 5), rr = r & 15, cc = c & 31, ob = rr * 64 + cc * 2; return st * 1024 + (ob ^ (((ob >> 9) & 1) << 5)); }
__host__ __device__ __forceinline__ void stage_rc(int b, int& R, int& C) { const int st = b / 1024, sb = b % 1024, swz = sb ^ (((sb >> 9) & 1) << 5); R = (st >> 1) * 16 + swz / 64; C = (st & 1) * 32 + (swz % 64) / 2; }
__host__ __device__ __forceinline__ int perm32(int rho) { const int n = rho >> 4, i = rho & 15; return 8 * (i >> 2) + 4 * n + (i & 3); }

struct Unit { int pm, pn; };
struct Gemm { const bf16_t* A; const bf16_t* Bt; int M, N, K; };

struct StaticOrder {
    int nM, nN, nwg, G, c;
    __host__ __device__ void init(int M, int N, int G_, int c_) { nM = M / BM; nN = N / BM; nwg = nM * nN; G = G_; c = c_; }
    __host__ __device__ bool next(int i, Unit& u) const {
        const long L = (long)i * G + c; if (L >= nwg) return false;
        int wgid = (int)L; { const int q = nwg / NXCD, r = nwg % NXCD, xcd = wgid % NXCD, off = wgid / NXCD; wgid = (xcd < r ? xcd * (q + 1) : r * (q + 1) + (xcd - r) * q) + off; }
        const int nig = WGM * nN, gid = wgid / nig, fm = gid * WGM, gsz = (nM - fm) < WGM ? (nM - fm) : WGM;
        u.pm = fm + ((wgid % nig) % gsz); u.pn = (wgid % nig) / gsz; return true;
    }
    __device__ __forceinline__ void a_ready(const Unit&) const {}
    __device__ __forceinline__ void done(const Unit&) const {}
};

__device__ __forceinline__ unsigned cvt_pk_bf16(float lo, float hi) { unsigned r; asm volatile("v_cvt_pk_bf16_f32 %0, %1, %2" : "=v"(r) : "v"(lo), "v"(hi)); return r; }
typedef float f32x2 __attribute__((ext_vector_type(2)));

typedef unsigned u32x2 __attribute__((ext_vector_type(2)));
__device__ __forceinline__ float silu_f(float x) { return x * __builtin_amdgcn_rcpf(1.0f + __builtin_amdgcn_exp2f(-1.4426950408889634f * x)); }

struct EpiProj {
    static constexpr bool PERM = false, AFTER_DRAIN = false;
    unsigned char* D; const float* r128; const float* r64;
    static constexpr size_t MB = 1u << 20, O_RQ = 0, O_RK = 32 * MB, O_RV = 64 * MB, O_RG = 96 * MB, O_AQ = 128 * MB, O_AK = 160 * MB, O_AV = 192 * MB, O_IQ = 224 * MB, O_IK = 256 * MB, O_IW = 260 * MB;
    __device__ __forceinline__ void operator()(const f32x4 (&acc)[2][2][4][2], const Unit& u, int wr, int wc, int fr, int fq) const {
        const int pn = u.pn; const int rowb = u.pm * BM + wr * 64 + fr;
        if (pn < 4 || (pn >= 8 && pn < 12)) {
            const bool isatt = pn >= 8, isk = (pn & 2) != 0; const float sc = (!isatt && isk) ? 0.08838834764831845f : 1.0f;
            const int i0 = 16 * wc + 4 * fq;
#pragma unroll
            for (int ai = 0; ai < 2; ++ai)
#pragma unroll
                for (int m = 0; m < 4; ++m) {
                    const int row = rowb + ai * HALF + m * 16;
                    const f32x4 cs0 = *(const f32x4*)(r128 + ((size_t)row * 64 + i0) * 2), cs1 = *(const f32x4*)(r128 + ((size_t)row * 64 + i0) * 2 + 4);
                    const float c[4] = {cs0[0], cs0[2], cs1[0], cs1[2]}, s[4] = {cs0[1], cs0[3], cs1[1], cs1[3]};
#pragma unroll
                    for (int bj = 0; bj < 2; ++bj) {
                        const f32x4 x1 = acc[ai][bj][m][0], x2 = acc[ai][bj][m][1]; float o1[4], o2[4];
#pragma unroll
                        for (int j = 0; j < 4; ++j) { o1[j] = (x1[j] * c[j] - x2[j] * s[j]) * sc; o2[j] = (x1[j] * s[j] + x2[j] * c[j]) * sc; }
                        const int head = 2 * (pn & 1) + bj; bf16_t* dst;
                        if (!isatt) dst = (bf16_t*)(D + (isk ? O_RK : O_RQ)) + (size_t)row * 512 + head * 128;
                        else dst = (bf16_t*)(D + (isk ? O_AK : O_AQ)) + ((size_t)((row >> 11) * 4 + head) * 2048 + (row & 2047)) * 128;
                        u32x2 w1, w2; w1.x = cvt_pk_bf16(o1[0], o1[1]); w1.y = cvt_pk_bf16(o1[2], o1[3]); w2.x = cvt_pk_bf16(o2[0], o2[1]); w2.y = cvt_pk_bf16(o2[2], o2[3]);
                        *(u32x2*)(dst + i0) = w1; *(u32x2*)(dst + 64 + i0) = w2;
                    }
                }
        } else if (pn < 14) {
            const bool isg = (pn == 6 || pn == 7), isav = pn >= 12;
            bf16_t* base = (bf16_t*)(D + (isav ? O_AV : (isg ? O_RG : O_RV)));
#pragma unroll
            for (int ai = 0; ai < 2; ++ai)
#pragma unroll
                for (int m = 0; m < 4; ++m) {
                    const int row = rowb + ai * HALF + m * 16;
#pragma unroll
                    for (int bj = 0; bj < 2; ++bj) {
                        f32x4 v0 = acc[ai][bj][m][0], v1 = acc[ai][bj][m][1];
                        if (isg) {
#pragma unroll
                            for (int j = 0; j < 4; ++j) { v0[j] = silu_f(v0[j]); v1[j] = silu_f(v1[j]); }
                        }
                        const int col = (pn & 1) * 256 + bj * HALF + wc * 32 + 8 * fq;
                        bf16_t* dst = isav ? base + ((size_t)((row >> 11) * 4 + (col >> 7)) * 2048 + (row & 2047)) * 128 + (col & 127) : base + (size_t)row * 512 + col;
                        u32x4 w; w.x = cvt_pk_bf16(v0[0], v0[1]); w.y = cvt_pk_bf16(v0[2], v0[3]); w.z = cvt_pk_bf16(v1[0], v1[1]); w.w = cvt_pk_bf16(v1[2], v1[3]);
                        *(u32x4*)dst = w;
                    }
                }
        } else {
            const int i0 = 16 * (wc & 1) + 4 * fq;
#pragma unroll
            for (int ai = 0; ai < 2; ++ai)
#pragma unroll
                for (int m = 0; m < 4; ++m) {
                    const int row = rowb + ai * HALF + m * 16;
                    if (pn < 16 || wc < 2) {
                        const f32x4 cs0 = *(const f32x4*)(r64 + ((size_t)row * 32 + i0) * 2), cs1 = *(const f32x4*)(r64 + ((size_t)row * 32 + i0) * 2 + 4);
                        const float c[4] = {cs0[0], cs0[2], cs1[0], cs1[2]}, s[4] = {cs0[1], cs0[3], cs1[1], cs1[3]};
#pragma unroll
                        for (int bj = 0; bj < 2; ++bj) {
                            if (pn == 16 && bj == 1) continue;
                            const f32x4 x1 = acc[ai][bj][m][0], x2 = acc[ai][bj][m][1]; float o1[4], o2[4];
                            const float sc = pn < 16 ? 0.125f : 1.0f;
#pragma unroll
                            for (int j = 0; j < 4; ++j) { o1[j] = (x1[j] * c[j] - x2[j] * s[j]) * sc; o2[j] = (x1[j] * s[j] + x2[j] * c[j]) * sc; }
                            bf16_t* dst = pn < 16 ? (bf16_t*)(D + O_IQ) + (size_t)row * 512 + (4 * (pn - 14) + 2 * bj + (wc >> 1)) * 64 : (bf16_t*)(D + O_IK) + (size_t)row * 64;
                            u32x2 w1, w2; w1.x = cvt_pk_bf16(o1[0], o1[1]); w1.y = cvt_pk_bf16(o1[2], o1[3]); w2.x = cvt_pk_bf16(o2[0], o2[1]); w2.y = cvt_pk_bf16(o2[2], o2[3]);
                            *(u32x2*)(dst + i0) = w1; *(u32x2*)(dst + 32 + i0) = w2;
                        }
                    } else if (wc == 2 && fq < 2) {
                        *(f32x4*)((float*)(D + O_IW) + (size_t)row * 8 + 4 * fq) = acc[ai][0][m][0] * 0.35355339059327373f;
                    }
                }
        }
    }
};
struct EpiRes {
    static constexpr bool PERM = false, AFTER_DRAIN = false;
    const float* base; float* out; float alpha;
    __device__ __forceinline__ void operator()(const f32x4 (&acc)[2][2][4][2], const Unit& u, int wr, int wc, int fr, int fq) const {
        const int rowb = u.pm * BM + wr * 64 + fr, colb = u.pn * BM + wc * 32 + 4 * fq;
#pragma unroll
        for (int ai = 0; ai < 2; ++ai)
#pragma unroll
            for (int m = 0; m < 4; ++m) { const size_t off = (size_t)(rowb + ai * HALF + m * 16) * 1024 + colb;
#pragma unroll
                for (int bj = 0; bj < 2; ++bj)
#pragma unroll
                    for (int n = 0; n < 2; ++n) { const f32x4 b = *(const f32x4*)(base + off + bj * HALF + n * 16); *(f32x4*)(out + off + bj * HALF + n * 16) = b * alpha + acc[ai][bj][m][n]; } }
    }
};
struct EpiSwiGLU {
    static constexpr bool PERM = false, AFTER_DRAIN = false;
    bf16_t* h;
    __device__ __forceinline__ void operator()(const f32x4 (&acc)[2][2][4][2], const Unit& u, int wr, int wc, int fr, int fq) const {
        const int rowb = u.pm * BM + wr * 64 + fr, colb = u.pn * 128 + wc * 32 + 8 * fq;
#pragma unroll
        for (int ai = 0; ai < 2; ++ai)
#pragma unroll
            for (int m = 0; m < 4; ++m) {
                const f32x4 g0 = acc[ai][0][m][0], g1 = acc[ai][0][m][1], u0 = acc[ai][1][m][0], u1 = acc[ai][1][m][1]; float o[8];
#pragma unroll
                for (int j = 0; j < 4; ++j) { o[j] = silu_f(g0[j]) * u0[j]; o[4 + j] = silu_f(g1[j]) * u1[j]; }
                u32x4 w; w.x = cvt_pk_bf16(o[0], o[1]); w.y = cvt_pk_bf16(o[2], o[3]); w.z = cvt_pk_bf16(o[4], o[5]); w.w = cvt_pk_bf16(o[6], o[7]);
                *(u32x4*)(h + (size_t)(rowb + ai * HALF + m * 16) * 2816 + colb) = w;
            }
    }
};
template <class Epi, class Sched, bool ALIGN_EPI = false, bool SP2 = false>
__device__ __forceinline__ void gemm_phase(PG8_LAS unsigned char* lds, const Gemm g, const Sched& S, const Epi& E) {
    const int tid = opaque_tid(), wid = __builtin_amdgcn_readfirstlane(tid >> 6), lane = tid & 63, wr = wid >> 2, wc = wid & 3, fr = lane & 15, fq = lane >> 4;
    const int K = g.K, nt = K / BK;
    unsigned voffA[2], voffB[2];
#pragma unroll
    for (int i = 0; i < 2; ++i) { int R, C; stage_rc(tid * 16 + i * 8192, R, C); const int Rb = Epi::PERM ? ((R & ~31) + perm32(R & 31)) : R;
        voffA[i] = (unsigned)(R * K + C) * 2u; voffB[i] = (unsigned)(Rb * K + C) * 2u; }
    const size_t kstep = (size_t)(BK * 2);
    const size_t hstep = (size_t)HALF * K * 2;
    const size_t tstep = 2 * hstep;
    const unsigned ldsw = (unsigned)wid * 1024u;
    const int aoff = lds_byte(wr * 64 + fr, fq * 8), boff = lds_byte(wc * 32 + fr, fq * 8);
#define PG8_SA(b, h) (((b) * 2 + (h)) * HTB)
#define PG8_SB(b, h) ((4 + (b) * 2 + (h)) * HTB)
#define PG8_STAGE(bufoff, gbase, voff) do { _Pragma("unroll") for (int _i = 0; _i < 2; ++_i) \
        __builtin_amdgcn_global_load_lds((const unsigned*)((const char*)(gbase) + (voff)[_i]), (PG8_LAS unsigned*)(lds + (bufoff) + ldsw + _i * 8192), 16, 0, 0); } while (0)
#define PG8_LDA(dst, b, h) do { _Pragma("unroll") for (int m = 0; m < 4; ++m) _Pragma("unroll") for (int k = 0; k < 2; ++k) dst[m][k] = *(const PG8_LAS bf16x8*)(lds + PG8_SA(b, h) + aoff + m * 2048 + k * 1024); } while (0)
#define PG8_LDB(dst, b, h) do { _Pragma("unroll") for (int n = 0; n < 2; ++n) _Pragma("unroll") for (int k = 0; k < 2; ++k) dst[n][k] = *(const PG8_LAS bf16x8*)(lds + PG8_SB(b, h) + boff + n * 2048 + k * 1024); } while (0)
#define PG8_MMA(ai, bj, At, Bt) do { __builtin_amdgcn_s_setprio(1); _Pragma("unroll") for (int m = 0; m < 4; ++m) _Pragma("unroll") for (int n = 0; n < 2; ++n) _Pragma("unroll") for (int k = 0; k < 2; ++k) \
        acc[ai][bj][m][n] = __builtin_amdgcn_mfma_f32_16x16x32_bf16(Bt[n][k], At[m][k], acc[ai][bj][m][n], 0, 0, 0); __builtin_amdgcn_s_setprio(0); } while (0)
#define PG8_WAIT_V(n) asm volatile("s_waitcnt vmcnt(" #n ")" ::: "memory")
#define PG8_WAIT_L(n) asm volatile("s_waitcnt lgkmcnt(" #n ")" ::: "memory")
#define PG8_BAR __builtin_amdgcn_s_barrier()
#define PG8_SCHED __builtin_amdgcn_sched_barrier(0)
    Unit cur, nxt; int ui = 0;
    if (!S.next(0, cur)) return;
    f32x4 acc[2][2][4][2];
#pragma unroll
    for (int a = 0; a < 2; ++a)
#pragma unroll
        for (int b = 0; b < 2; ++b)
#pragma unroll
            for (int m = 0; m < 4; ++m)
#pragma unroll
                for (int n = 0; n < 2; ++n) acc[a][b][m][n] = (f32x4){0.f, 0.f, 0.f, 0.f};
    bf16x8 At[4][2], B0[2][2], B1[2][2];
    const char* cA = (const char*)g.A + (size_t)cur.pm * tstep; const char* cB = (const char*)g.Bt + (size_t)cur.pn * tstep;
    S.a_ready(cur);
    if constexpr (SP2) {
        PG8_STAGE(PG8_SB(0, 0), cB, voffB); PG8_STAGE(PG8_SB(0, 1), cB + hstep, voffB); PG8_STAGE(PG8_SA(0, 0), cA, voffA); PG8_STAGE(PG8_SA(0, 1), cA + hstep, voffA);
        if (wr == 1) PG8_BAR;
        PG8_WAIT_V(2); PG8_BAR;
        PG8_STAGE(PG8_SB(1, 0), cB + kstep, voffB); PG8_STAGE(PG8_SA(1, 0), cA + kstep, voffA); PG8_STAGE(PG8_SB(1, 1), cB + hstep + kstep, voffB);
        PG8_WAIT_V(6); PG8_BAR;
    } else {
        PG8_STAGE(PG8_SB(0, 0), cB, voffB); PG8_STAGE(PG8_SA(0, 0), cA, voffA); PG8_STAGE(PG8_SB(0, 1), cB + hstep, voffB); PG8_STAGE(PG8_SA(0, 1), cA + hstep, voffA);
        if (wr == 1) PG8_BAR;
        PG8_WAIT_V(4); PG8_BAR;
        PG8_STAGE(PG8_SB(1, 0), cB + kstep, voffB); PG8_STAGE(PG8_SA(1, 0), cA + kstep, voffA); PG8_STAGE(PG8_SB(1, 1), cB + hstep + kstep, voffB);
        PG8_WAIT_V(6); PG8_BAR;
    }
    for (;;) {
        const bool has_next = S.next(ui + 1, nxt);
        const char* nA = has_next ? (const char*)g.A + (size_t)nxt.pm * tstep : cA; const char* nB = has_next ? (const char*)g.Bt + (size_t)nxt.pn * tstep : cB;
        for (int t = 0; t < nt; t += 2) {
            const bool last = (t == nt - 2);
            const char* a1 = cA + (size_t)(t + 1) * kstep;
            const char* a2 = last ? nA : cA + (size_t)(t + 2) * kstep; const char* b2 = last ? nB : cB + (size_t)(t + 2) * kstep;
            const char* a3 = a2 + kstep; const char* b3 = b2 + kstep;
            if (last && has_next) S.a_ready(nxt);
            if constexpr (SP2) {
            PG8_LDB(B0, 0, 0); PG8_LDB(B1, 0, 1); PG8_SCHED; PG8_LDA(At, 0, 0); PG8_STAGE(PG8_SA(1, 1), a1 + hstep, voffA);
            PG8_WAIT_V(8); PG8_WAIT_L(0); PG8_BAR; PG8_MMA(0, 0, At, B0); PG8_MMA(0, 1, At, B1); PG8_BAR; PG8_SCHED;
            PG8_LDA(At, 0, 1); PG8_STAGE(PG8_SB(0, 0), b2, voffB); PG8_STAGE(PG8_SB(0, 1), b2 + hstep, voffB); PG8_STAGE(PG8_SA(0, 0), a2, voffA);
            PG8_WAIT_V(8); PG8_WAIT_L(0); PG8_BAR; PG8_MMA(1, 0, At, B0); PG8_MMA(1, 1, At, B1); PG8_BAR; PG8_SCHED;
            PG8_LDB(B0, 1, 0); PG8_LDB(B1, 1, 1); PG8_SCHED; PG8_LDA(At, 1, 0); PG8_STAGE(PG8_SA(0, 1), a2 + hstep, voffA);
            PG8_WAIT_V(8); PG8_WAIT_L(0); PG8_BAR; PG8_MMA(0, 0, At, B0); PG8_MMA(0, 1, At, B1); PG8_BAR; PG8_SCHED;
            PG8_LDA(At, 1, 1); PG8_STAGE(PG8_SB(1, 0), b3, voffB); PG8_STAGE(PG8_SB(1, 1), b3 + hstep, voffB); PG8_STAGE(PG8_SA(1, 0), a3, voffA);
            PG8_WAIT_V(8); PG8_WAIT_L(0); PG8_BAR; PG8_MMA(1, 0, At, B0); PG8_MMA(1, 1, At, B1); PG8_BAR; PG8_SCHED;
            } else {
            PG8_LDB(B0, 0, 0); PG8_SCHED; PG8_LDA(At, 0, 0); PG8_STAGE(PG8_SA(1, 1), a1 + hstep, voffA);
            PG8_WAIT_L(8); PG8_BAR; PG8_WAIT_L(0); PG8_MMA(0, 0, At, B0); PG8_BAR; PG8_SCHED;
            PG8_LDB(B1, 0, 1); PG8_STAGE(PG8_SB(0, 0), b2, voffB);
            PG8_BAR; PG8_WAIT_L(0); PG8_MMA(0, 1, At, B1); PG8_BAR;
            PG8_LDA(At, 0, 1); PG8_STAGE(PG8_SA(0, 0), a2, voffA);
            PG8_BAR; PG8_WAIT_L(0); PG8_MMA(1, 0, At, B0); PG8_BAR; PG8_SCHED;
            PG8_STAGE(PG8_SB(0, 1), b2 + hstep, voffB);
            PG8_WAIT_V(6); PG8_BAR; PG8_MMA(1, 1, At, B1); PG8_BAR;
            PG8_LDB(B0, 1, 0); PG8_SCHED; PG8_LDA(At, 1, 0); PG8_STAGE(PG8_SA(0, 1), a2 + hstep, voffA);
            PG8_WAIT_L(8); PG8_BAR; PG8_WAIT_L(0); PG8_MMA(0, 0, At, B0); PG8_BAR; PG8_SCHED;
            PG8_LDB(B1, 1, 1); PG8_STAGE(PG8_SB(1, 0), b3, voffB);
            PG8_BAR; PG8_WAIT_L(0); PG8_MMA(0, 1, At, B1); PG8_BAR;
            PG8_LDA(At, 1, 1); PG8_STAGE(PG8_SA(1, 0), a3, voffA);
            PG8_BAR; PG8_WAIT_L(0); PG8_MMA(1, 0, At, B0); PG8_BAR; PG8_SCHED;
            PG8_STAGE(PG8_SB(1, 1), b3 + hstep, voffB);
            PG8_WAIT_V(6); PG8_BAR; PG8_MMA(1, 1, At, B1); PG8_BAR;
            }
        }
        if constexpr (ALIGN_EPI) { if (wr == 0) PG8_BAR; }
        if constexpr (!Epi::AFTER_DRAIN) { E(acc, cur, wr, wc, fr, fq); S.done(cur); }
        if (!has_next) break;
#pragma unroll
        for (int a = 0; a < 2; ++a)
#pragma unroll
            for (int b = 0; b < 2; ++b)
#pragma unroll
                for (int m = 0; m < 4; ++m)
#pragma unroll
                    for (int n = 0; n < 2; ++n) acc[a][b][m][n] = (f32x4){0.f, 0.f, 0.f, 0.f};
        cur = nxt; cA = nA; cB = nB; ++ui;
        if constexpr (ALIGN_EPI) { if (wr == 1) PG8_BAR; }
    }
    PG8_WAIT_V(0);
    if constexpr (!ALIGN_EPI) { if (wr == 0) PG8_BAR; }
    PG8_BAR;
    if constexpr (Epi::AFTER_DRAIN) { E.fused(acc, cur, wr, wc, fr, fq, lds, wid, lane); S.done(cur); }
#undef PG8_SA
#undef PG8_SB
#undef PG8_STAGE
#undef PG8_LDA
#undef PG8_LDB
#undef PG8_MMA
#undef PG8_WAIT_V
#undef PG8_WAIT_L
#undef PG8_BAR
#undef PG8_SCHED
}
}

#define GAS __attribute__((address_space(1)))
#define LAS __attribute__((address_space(3)))
typedef unsigned short bf16;
typedef unsigned v4u __attribute__((ext_vector_type(4)));
typedef unsigned v2u __attribute__((ext_vector_type(2)));
typedef float f32x4 __attribute__((ext_vector_type(4)));
typedef float f32x16 __attribute__((ext_vector_type(16)));
typedef short bf16x8 __attribute__((ext_vector_type(8)));
typedef unsigned long long u64;

constexpr int BATCH = 16, SEQ = 2048, DM = 1024, DEPTH = 2, M = BATCH * SEQ;
constexpr int IN_COLS = 4168, IN_POS = 4352, FFN = 2816, TOPK = 256;
constexpr float LN_EPS = 1e-5f;
constexpr float DN_ALPHA = 1.4142135623730951f;
constexpr size_t MiB = 1u << 20;
constexpr size_t WS_CTL = 0, CTL_BYTES = 1 * MiB;
constexpr size_t WS_WIN = 1 * MiB, WS_WOUT = 10 * MiB, WS_WGU = 12 * MiB, WS_WDN = 23 * MiB;
constexpr size_t WS_R128 = 29 * MiB, WS_R64 = 45 * MiB;
constexpr size_t WS_B = 53 * MiB;
constexpr size_t WS_C = 117 * MiB;
constexpr size_t WS_D = 245 * MiB;
constexpr size_t D_RQ = 0, D_RK = 32 * MiB, D_RV = 64 * MiB, D_RG = 96 * MiB, D_AQ = 128 * MiB, D_AK = 160 * MiB, D_AV = 192 * MiB, D_IQ = 224 * MiB, D_IK = 256 * MiB, D_IW = 260 * MiB;
constexpr size_t D_H = 0, D_X1B = 176 * MiB;
constexpr size_t WS_END = 506 * MiB;
constexpr size_t O_KV = 0, O_MASK = 64 * MiB;

struct Args { const void* in[11]; float* out; unsigned char* ws; int layer, ph_lo, ph_hi, pad; };

__device__ __forceinline__ unsigned f2bf(float f) { unsigned u = __builtin_bit_cast(unsigned, f); return (u + 0x7fffu + ((u >> 16) & 1u)) >> 16; }
__device__ __forceinline__ unsigned pk2(float lo, float hi) { return f2bf(lo) | (f2bf(hi) << 16); }
__device__ __forceinline__ float bf2f(unsigned short b) { return __builtin_bit_cast(float, (unsigned)b << 16); }
__device__ __forceinline__ float wave_sum(float v) {
#pragma unroll
    for (int o = 1; o < 64; o <<= 1) v += __shfl_xor(v, o);
    return v;
}

__device__ __forceinline__ int map_in(int p) {
    const int pn = p >> 8, q = p & 255;
    if (pn < 4 || (pn >= 8 && pn < 12)) { const int blk = q >> 7, q7 = q & 127, wc = q7 >> 5, n = (q7 >> 4) & 1, r = q7 & 15; return pn * 256 + blk * 128 + 64 * n + 16 * wc + r; }
    if (pn < 14) { const int g = q >> 5, q5 = q & 31, n = q5 >> 4, fq = (q5 >> 2) & 3, j = q5 & 3; return pn * 256 + g * 32 + 8 * fq + 4 * n + j; }
    if (pn < 16 || q < 64) { const int B = q >> 6, q6 = q & 63, w = q6 >> 5, n = (q6 >> 4) & 1, r = q6 & 15; return pn * 256 + B * 64 + 32 * n + 16 * w + r; }
    if (q < 72) return 4096 + q;
    return -1;
}
__device__ __forceinline__ int map_gu(int p) { const int pn = p >> 8, q = p & 255, bj = q >> 7, q7 = q & 127, wc = q7 >> 5, n = (q7 >> 4) & 1, fq = (q7 >> 2) & 3, j = q7 & 3; return bj * FFN + pn * 128 + 32 * wc + 8 * fq + 4 * n + j; }
template <int MAP> __device__ __forceinline__ void transpose_item(const float* W, int K, int Nsrc, bf16* WT, LAS float* scr, int item, int nblk, int lane) {
    const int kb = item / nblk, nb = item % nblk, k0 = 64 * kb, n0 = 32 * nb;
    const int p = n0 + (lane & 31); const int sc = MAP == 0 ? p : (MAP == 1 ? map_in(p) : map_gu(p));
#pragma unroll 8
    for (int i = 0; i < 32; ++i) { const int kk = 2 * i + (lane >> 5); scr[kk * 33 + (lane & 31)] = sc >= 0 ? W[(size_t)(k0 + kk) * Nsrc + sc] : 0.f; }
    asm volatile("s_waitcnt lgkmcnt(0)" ::: "memory");
    const int c = lane & 7;
#pragma unroll
    for (int j = 0; j < 4; ++j) { const int n = (lane >> 3) + 8 * j; const LAS float* s = scr + (8 * c) * 33 + n;
        v4u o; o.x = pk2(s[0 * 33], s[1 * 33]); o.y = pk2(s[2 * 33], s[3 * 33]); o.z = pk2(s[4 * 33], s[5 * 33]); o.w = pk2(s[6 * 33], s[7 * 33]);
        *(v4u*)(WT + (size_t)(n0 + n) * K + k0 + 8 * c) = o; }
    asm volatile("s_waitcnt lgkmcnt(0)" ::: "memory");
}
__device__ __forceinline__ void convert_weights(const Args& a, int layer, int gw, int ngw, LAS float* scr, int lane) {
    const float* w_in = (const float*)a.in[2] + (size_t)layer * DM * IN_COLS; const float* w_out = (const float*)a.in[4] + (size_t)layer * DM * DM;
    const float* w_gu = (const float*)a.in[7] + (size_t)layer * DM * 2 * FFN; const float* w_dn = (const float*)a.in[8] + (size_t)layer * FFN * DM;
    bf16* WIN = (bf16*)(a.ws + WS_WIN); bf16* WOUT = (bf16*)(a.ws + WS_WOUT); bf16* WGU = (bf16*)(a.ws + WS_WGU); bf16* WDN = (bf16*)(a.ws + WS_WDN);
    constexpr int I_IN = (DM / 64) * (IN_POS / 32), I_OUT = (DM / 64) * (DM / 32), I_GU = (DM / 64) * (2 * FFN / 32), I_DN = (FFN / 64) * (DM / 32);
    for (int it = gw; it < I_IN + I_OUT + I_GU + I_DN; it += ngw) {
        int r = it;
        if (r < I_IN) { transpose_item<1>(w_in, DM, IN_COLS, WIN, scr, r, IN_POS / 32, lane); continue; } r -= I_IN;
        if (r < I_OUT) { transpose_item<0>(w_out, DM, DM, WOUT, scr, r, DM / 32, lane); continue; } r -= I_OUT;
        if (r < I_GU) { transpose_item<2>(w_gu, DM, 2 * FFN, WGU, scr, r, 2 * FFN / 32, lane); continue; } r -= I_GU;
        transpose_item<0>(w_dn, FFN, DM, WDN, scr, r, DM / 32, lane);
    }
}
__device__ __forceinline__ void convert_x_and_rope(const Args& a, int gt, int ngt) {
    const float* x = (const float*)a.in[0]; bf16* xb = (bf16*)(a.ws + WS_B);
    for (size_t i = gt; i < (size_t)M * DM / 8; i += ngt) { const f32x4 v0 = *(const f32x4*)(x + i * 8), v1 = *(const f32x4*)(x + i * 8 + 4);
        v4u o; o.x = pk2(v0[0], v0[1]); o.y = pk2(v0[2], v0[3]); o.z = pk2(v1[0], v1[1]); o.w = pk2(v1[2], v1[3]); *(v4u*)(xb + i * 8) = o; }
    const int* pos = (const int*)a.in[1]; float* r128 = (float*)(a.ws + WS_R128); float* r64 = (float*)(a.ws + WS_R64);
    for (int i = gt; i < M * 64; i += ngt) { const int row = i >> 6, f = i & 63;
        const float inv = (float)exp2(-(double)f * (13.287712379549449 / 64.0));
        const float ang = (float)pos[row] * inv;
        double rev = (double)ang * 0.15915494309189535; rev -= floor(rev); if (rev > 0.5) rev -= 1.0;
        const float r = (float)(rev * 6.283185307179586);
        const float c = cosf(r), s = sinf(r);
        r128[(size_t)i * 2] = c; r128[(size_t)i * 2 + 1] = s;
        if ((f & 1) == 0) { r64[((size_t)row * 32 + (f >> 1)) * 2] = c; r64[((size_t)row * 32 + (f >> 1)) * 2 + 1] = s; } }
}
__device__ __forceinline__ void ln_rows(const float* in, const float* g, const float* bta, float* outf, bf16* outb, int gw, int ngw, int lane) {
    f32x4 gv[4], bv[4];
#pragma unroll
    for (int j = 0; j < 4; ++j) { gv[j] = *(const f32x4*)(g + 4 * lane + 256 * j); bv[j] = *(const f32x4*)(bta + 4 * lane + 256 * j); }
    for (int m = gw; m < M; m += ngw) {
        const f32x4* xr = (const f32x4*)(in + (size_t)m * DM) + lane; f32x4 v[4]; float s = 0.f;
#pragma unroll
        for (int j = 0; j < 4; ++j) { v[j] = xr[64 * j]; s += (v[j][0] + v[j][1]) + (v[j][2] + v[j][3]); }
        const float mean = wave_sum(s) * (1.f / DM); float s2 = 0.f;
#pragma unroll
        for (int j = 0; j < 4; ++j) { v[j] = v[j] - mean; s2 += (v[j][0] * v[j][0] + v[j][1] * v[j][1]) + (v[j][2] * v[j][2] + v[j][3] * v[j][3]); }
        const float rstd = 1.f / sqrtf(wave_sum(s2) * (1.f / DM) + LN_EPS);
#pragma unroll
        for (int j = 0; j < 4; ++j) { const f32x4 y = v[j] * rstd * gv[j] + bv[j];
            *((f32x4*)(outf + (size_t)m * DM) + lane + 64 * j) = y;
            if (outb) { v2u o; o.x = pk2(y[0], y[1]); o.y = pk2(y[2], y[3]); *((v2u*)(outb + (size_t)m * DM) + lane + 64 * j) = o; } }
    }
}

__device__ __forceinline__ unsigned okey(float f) { const unsigned u = __builtin_bit_cast(unsigned, f); return (u & 0x80000000u) ? ~u : (u | 0x80000000u); }

constexpr int TS = 272;
constexpr int TILE_B = 128 * TS;
__device__ __forceinline__ int crow(int r, int hi) { return (r & 3) + 8 * (r >> 2) + 4 * hi; }
__device__ __forceinline__ void mm128(f32x16 (&acc)[2], const LAS unsigned char* A, const LAS unsigned char* Bt, int wr, int wc, int r32, int hi) {
    const LAS unsigned char* ap = A + (32 * wr + r32) * TS + hi * 16; const LAS unsigned char* bp = Bt + (64 * wc + r32) * TS + hi * 16;
#pragma unroll
    for (int s = 0; s < 8; ++s) {
        const bf16x8 av = *(const LAS bf16x8*)(ap + s * 32), b0 = *(const LAS bf16x8*)(bp + s * 32), b1 = *(const LAS bf16x8*)(bp + 32 * TS + s * 32);
        acc[0] = __builtin_amdgcn_mfma_f32_32x32x16_bf16(av, b0, acc[0], 0, 0, 0); acc[1] = __builtin_amdgcn_mfma_f32_32x32x16_bf16(av, b1, acc[1], 0, 0, 0);
    }
}
__device__ __forceinline__ void tile_load_nat(LAS unsigned char* T, const bf16* g, int ld, int tid) {
#pragma unroll
    for (int i = 0; i < 4; ++i) { const int row = (tid >> 4) + 32 * i, ch = tid & 15; *(LAS v4u*)(T + row * TS + ch * 16) = *(const v4u*)(g + (size_t)row * ld + ch * 8); }
}
template <bool SC> __device__ __forceinline__ void tile_load_tr(LAS unsigned char* T, const bf16* g, int ld, int tid, float sc) {
    const int j = tid & 127;
#pragma unroll
    for (int i = 0; i < 4; ++i) { const int c8 = (tid >> 7) + 4 * i; const v4u v = *(const v4u*)(g + (size_t)j * ld + c8 * 8);
#pragma unroll
        for (int q = 0; q < 8; ++q) { unsigned x = (v[q >> 1] >> ((q & 1) * 16)) & 0xffffu; if (SC) x = f2bf(bf2f((unsigned short)x) * sc);
            *(LAS unsigned short*)(T + (c8 * 8 + q) * TS + j * 2) = (unsigned short)x; } }
}
__device__ __forceinline__ void ret_kv_phase(LAS unsigned char* lds, const Args& a, int blk, int nblk) {
    const int tid = opaque_tid(), lane = tid & 63, wid = __builtin_amdgcn_readfirstlane(tid >> 6), r32 = lane & 31, hi = lane >> 5, wr = wid >> 1, wc = wid & 1;
    LAS unsigned char* Tv = lds; LAS unsigned char* Tk = lds + TILE_B;
    const bf16* rk = (const bf16*)(a.ws + WS_D + D_RK); const bf16* rv = (const bf16*)(a.ws + WS_D + D_RV); float* kvT = (float*)((unsigned char*)a.out + O_KV);
    for (int it = blk; it < 1024; it += nblk) {
        const int n = it & 15, h = (it >> 4) & 3, b = it >> 6;
        if (n == 15) continue;
        const float l2g = log2f(1.0f - exp2f(-5.0f - (float)h));
        const size_t row0 = (size_t)b * SEQ + n * 128;
        tile_load_tr<false>(Tv, rv + row0 * 512 + h * 128, 512, tid, 1.f);
        tile_load_tr<true>(Tk, rk + row0 * 512 + h * 128, 512, tid, exp2f((float)(127 - (tid & 127)) * l2g));
        __syncthreads();
        f32x16 acc[2]; acc[0] = f32x16{}; acc[1] = f32x16{};
        mm128(acc, Tv, Tk, wr, wc, r32, hi);
        float* o = kvT + (size_t)it * 16384;
#pragma unroll
        for (int ct = 0; ct < 2; ++ct)
#pragma unroll
            for (int r = 0; r < 16; ++r) o[(32 * wr + crow(r, hi)) * 128 + 64 * wc + 32 * ct + r32] = acc[ct][r];
        __syncthreads();
    }
}
__device__ __forceinline__ void ret_out_phase(LAS unsigned char* lds, const Args& a, int blk, int nblk) {
    const int tid = opaque_tid(), lane = tid & 63, wid = __builtin_amdgcn_readfirstlane(tid >> 6), r32 = lane & 31, hi = lane >> 5, wr = wid >> 1, wc = wid & 1;
    LAS unsigned char* Tq = lds; LAS unsigned char* Tk = lds + TILE_B; LAS unsigned char* Tv = lds + 2 * TILE_B; LAS unsigned char* Tst = lds + 3 * TILE_B;
    LAS float* Of = (LAS float*)lds;
    unsigned char* D = a.ws + WS_D; const bf16* rq = (const bf16*)(D + D_RQ); const bf16* rk = (const bf16*)(D + D_RK); const bf16* rv = (const bf16*)(D + D_RV); const bf16* rg = (const bf16*)(D + D_RG);
    const float* kvT = (const float*)((const unsigned char*)a.out + O_KV); bf16* mix = (bf16*)(a.ws + WS_B); const float* gain = (const float*)a.in[3] + a.layer * 512;
    for (int it = blk; it < 1024; it += nblk) {
        const int n = it & 15, h = (it >> 4) & 3, b = it >> 6;
        const float l2g = log2f(1.0f - exp2f(-5.0f - (float)h));
        const size_t row0 = (size_t)b * SEQ + n * 128;
        tile_load_nat(Tq, rq + row0 * 512 + h * 128, 512, tid);
        tile_load_nat(Tk, rk + row0 * 512 + h * 128, 512, tid);
        tile_load_tr<false>(Tv, rv + row0 * 512 + h * 128, 512, tid, 1.f);
        if (n > 0) {
            f32x4 s[8];
#pragma unroll
            for (int k = 0; k < 8; ++k) s[k] = (f32x4){0.f, 0.f, 0.f, 0.f};
            for (int m = 0; m < n; ++m) { const float w = exp2f((float)(128 * (n - 1 - m)) * l2g); const f32x4* src = (const f32x4*)(kvT + (size_t)((it & ~15) + m) * 16384) + tid;
#pragma unroll
                for (int k = 0; k < 8; ++k) s[k] += src[512 * k] * w; }
#pragma unroll
            for (int k = 0; k < 8; ++k) { const int idx = tid + 512 * k, e = idx >> 5, d4 = idx & 31; v2u o; o.x = pk2(s[k][0], s[k][1]); o.y = pk2(s[k][2], s[k][3]); *(LAS v2u*)(Tst + e * TS + d4 * 8) = o; }
        }
        __syncthreads();
        f32x16 acc[2]; acc[0] = f32x16{}; acc[1] = f32x16{};
        mm128(acc, Tq, Tk, wr, wc, r32, hi);
        __syncthreads();
#pragma unroll
        for (int ct = 0; ct < 2; ++ct)
#pragma unroll
            for (int r = 0; r < 16; ++r) { const int i = 32 * wr + crow(r, hi), j = 64 * wc + 32 * ct + r32;
                const float p = i >= j ? acc[ct][r] * exp2f((float)(i - j) * l2g) : 0.f;
                *(LAS unsigned short*)(Tk + i * TS + j * 2) = (unsigned short)f2bf(p); }
        __syncthreads();
        acc[0] = f32x16{}; acc[1] = f32x16{};
        if (n > 0) {
            mm128(acc, Tq, Tst, wr, wc, r32, hi);
#pragma unroll
            for (int r = 0; r < 16; ++r) { const float dq = exp2f((float)(32 * wr + crow(r, hi) + 1) * l2g); acc[0][r] *= dq; acc[1][r] *= dq; }
        }
        mm128(acc, Tk, Tv, wr, wc, r32, hi);
        __syncthreads();
#pragma unroll
        for (int ct = 0; ct < 2; ++ct)
#pragma unroll
            for (int r = 0; r < 16; ++r) Of[(32 * wr + crow(r, hi)) * 132 + 64 * wc + 32 * ct + r32] = acc[ct][r];
        __syncthreads();
        const float g0 = gain[h * 128 + 2 * lane], g1 = gain[h * 128 + 2 * lane + 1];
#pragma unroll 4
        for (int rr = 0; rr < 16; ++rr) { const int row = 16 * wid + rr;
            const float v0 = Of[row * 132 + 2 * lane], v1 = Of[row * 132 + 2 * lane + 1];
            const float mean = wave_sum(v0 + v1) * (1.f / 128.f); const float d0 = v0 - mean, d1 = v1 - mean;
            const float rs = 1.0f / sqrtf(wave_sum(d0 * d0 + d1 * d1) * (1.f / 128.f) + LN_EPS);
            const unsigned gg = *(const unsigned*)(rg + (row0 + row) * 512 + h * 128 + 2 * lane);
            *(unsigned*)(mix + (row0 + row) * 1024 + h * 128 + 2 * lane) = pk2(d0 * rs * g0 * bf2f((unsigned short)(gg & 0xffffu)), d1 * rs * g1 * bf2f((unsigned short)(gg >> 16))); }
        __syncthreads();
    }
}
constexpr int SROW = 2052;
__device__ __forceinline__ void idx_phase(LAS unsigned char* lds, const Args& a, int blk, int nblk) {
    const int tid = opaque_tid(), lane = tid & 63, wid = __builtin_amdgcn_readfirstlane(tid >> 6), c = lane & 15, g = lane >> 4;
    LAS float* Sc = (LAS float*)lds;
    unsigned char* D = a.ws + WS_D; const bf16* iq = (const bf16*)(D + D_IQ); const bf16* ik = (const bf16*)(D + D_IK); const float* iw = (const float*)(D + D_IW);
    u64* mask = (u64*)((unsigned char*)a.out + O_MASK);
    for (int it = blk; it < BATCH * 64; it += nblk) {
        const int b = it >> 6, qb = it & 63;
        for (int half = 0; half < 2; ++half) {
            const int q0 = qb * 32 + half * 16, ntile = q0 / 16 + 1;
            {
                const size_t rowq = (size_t)b * SEQ + q0 + c;
                bf16x8 qf[8][2];
#pragma unroll
                for (int h = 0; h < 8; ++h) { qf[h][0] = *(const bf16x8*)(iq + rowq * 512 + h * 64 + g * 8); qf[h][1] = *(const bf16x8*)(iq + rowq * 512 + h * 64 + 32 + g * 8); }
                const f32x4 w0 = *(const f32x4*)(iw + rowq * 8), w1 = *(const f32x4*)(iw + rowq * 8 + 4);
                const float wv[8] = {w0[0], w0[1], w0[2], w0[3], w1[0], w1[1], w1[2], w1[3]};
                for (int kt = wid; kt < ntile; kt += 8) {
                    const size_t krow = (size_t)b * SEQ + kt * 16 + c;
                    const bf16x8 kf0 = *(const bf16x8*)(ik + krow * 64 + g * 8), kf1 = *(const bf16x8*)(ik + krow * 64 + 32 + g * 8);
                    f32x4 sc = (f32x4){0.f, 0.f, 0.f, 0.f};
#pragma unroll
                    for (int h = 0; h < 8; ++h) { f32x4 ac = __builtin_amdgcn_mfma_f32_16x16x32_bf16(kf0, qf[h][0], (f32x4){0.f, 0.f, 0.f, 0.f}, 0, 0, 0);
                        ac = __builtin_amdgcn_mfma_f32_16x16x32_bf16(kf1, qf[h][1], ac, 0, 0, 0);
#pragma unroll
                        for (int r = 0; r < 4; ++r) sc[r] = fmaf(wv[h], fmaxf(ac[r], 0.f), sc[r]); }
#pragma unroll
                    for (int r = 0; r < 4; ++r) sc[r] += 0.0f;
                    *(LAS f32x4*)(Sc + c * SROW + kt * 16 + 4 * g) = sc;
                }
            }
            __syncthreads();
            for (int u = 0; u < 2; ++u) {
                const int cq = 2 * wid + u, t = q0 + cq;
                unsigned key[32];
#pragma unroll
                for (int i = 0; i < 32; ++i) { const int idx = 64 * i + lane; key[i] = 0u; if (idx <= t) key[i] = okey(Sc[cq * SROW + idx]); }
                u64 myw = 0ull;
                if (t < TOPK) {
#pragma unroll
                    for (int i = 0; i < 32; ++i) { const u64 w = __ballot(64 * i + lane <= t); if (lane == i) myw = w; }
                } else {
                    const int imax = t / 64 + 1;
                    unsigned thr = 0u;
                    for (int bit = 31; bit >= 0; --bit) { const unsigned cand = thr | (1u << bit); int cnt = 0;
#pragma unroll
                        for (int gq = 0; gq < 4; ++gq) if (imax > 8 * gq) {
#pragma unroll
                            for (int i = 8 * gq; i < 8 * gq + 8; ++i) cnt += __popcll(__ballot(key[i] >= cand)); }
                        if (cnt >= TOPK) thr = cand; }
                    int cgt = 0;
#pragma unroll
                    for (int i = 0; i < 32; ++i) cgt += __popcll(__ballot(key[i] > thr));
                    const int need = TOPK - cgt; int eqc = 0;
#pragma unroll
                    for (int i = 0; i < 32; ++i) { const bool eq = key[i] == thr; const u64 em = __ballot(eq);
                        const int rank = eqc + (int)__builtin_amdgcn_mbcnt_hi((unsigned)(em >> 32), __builtin_amdgcn_mbcnt_lo((unsigned)em, 0u));
                        const u64 w = __ballot(key[i] > thr || (eq && rank < need)); eqc += __popcll(em); if (lane == i) myw = w; }
                }
                if (lane < 32) mask[((size_t)b * 32 + lane) * SEQ + t] = myw;
            }
            __syncthreads();
        }
    }
}

namespace att {
constexpr int D = 128, NW = 8, QBLK = 32, KVBLK = 64, QB = NW * QBLK, LDO = 1024;
constexpr int SHM_V = KVBLK * D * 2, SHM_K = KVBLK * D * 2;
constexpr int LDS_BYTES = 2 * SHM_V + 2 * SHM_K + NW * 64 * 4;
constexpr float SCALE = 0.08838834764831845f, THR = 8.f;
typedef short s16x4 __attribute__((ext_vector_type(4)));
#define KSWZ(row, colB) ((row) * 256 + ((colB) ^ (((row) & 7) << 4)))
#define SBAR() __builtin_amdgcn_sched_barrier(0)
__device__ __forceinline__ int v_st(int k, int c) { const int kk = (k & ~0xC) | ((k & 4) << 1) | ((k & 8) >> 1); return ((kk >> 3) * 4 + (c >> 5)) * 512 + ((kk & 7) * 32 + (c & 31)) * 2; }
__device__ __forceinline__ int v_rd_base(int lane) { return ((lane & 3) << 3) | (((lane >> 2) & 3) << 6) | (((lane >> 4) & 1) << 5) | (((lane >> 5) & 1) << 8); }
constexpr int v_rd_off(int d0, int ks, int half) { return d0 * 512 + ks * 4096 + half * 2048; }
__device__ __forceinline__ unsigned cvtpk(float lo, float hi) { unsigned r; asm volatile("v_cvt_pk_bf16_f32 %0, %1, %2" : "=v"(r) : "v"(lo), "v"(hi)); return r; }
__device__ __forceinline__ bf16x8 load8(const bf16* p) { return *reinterpret_cast<const bf16x8*>(p); }
__device__ __forceinline__ void mask_bits(f32x16& p0, f32x16& p1, u64 mw, int hi) {
    const float NEG = -__builtin_inff();
    const unsigned lo = (unsigned)mw >> (4 * hi), h2 = (unsigned)(mw >> 32) >> (4 * hi);
#pragma unroll
    for (int r = 0; r < 16; ++r) { const int c = (r & 3) + 8 * (r >> 2);
        if (!((lo >> c) & 1u)) p0[r] = NEG;
        if (!((h2 >> c) & 1u)) p1[r] = NEG; }
}
__device__ __forceinline__ void partialSM(f32x16& p0, f32x16& p1, float& m_reg, float& mn, float& alpha) {
    float pmax = p0[0]; for (int r = 1; r < 16; ++r) pmax = fmaxf(pmax, p0[r]); for (int r = 0; r < 16; ++r) pmax = fmaxf(pmax, p1[r]);
    { auto rr = __builtin_amdgcn_permlane32_swap(__float_as_uint(pmax), __float_as_uint(pmax), false, false);
      pmax = fmaxf(__uint_as_float(rr[0]), __uint_as_float(rr[1])); }
    constexpr float C2 = 1.4426950408889634f * SCALE;
    if (__builtin_expect(__all((pmax - m_reg) * SCALE <= THR), 1)) { mn = m_reg; alpha = 1.f; }
    else { mn = fmaxf(m_reg, pmax); alpha = __builtin_amdgcn_exp2f((m_reg - mn) * C2); m_reg = mn; }
    const float mnL = -mn * C2;
    for (int r = 0; r < 16; ++r) p0[r] = fmaf(p0[r], C2, mnL); for (int r = 0; r < 16; ++r) p1[r] = fmaf(p1[r], C2, mnL);
    for (int r = 0; r < 16; ++r) p0[r] = __builtin_amdgcn_exp2f(p0[r]);
}
__device__ __forceinline__ void finishSM(f32x16& p0, f32x16& p1, float alpha, float& l_reg, bf16x8& pa0, bf16x8& pa1, bf16x8& pa2, bf16x8& pa3) {
    for (int r = 0; r < 16; ++r) p1[r] = __builtin_amdgcn_exp2f(p1[r]);
    float ps = 0; for (int r = 0; r < 16; ++r) ps += p0[r]; for (int r = 0; r < 16; ++r) ps += p1[r];
    { auto rr = __builtin_amdgcn_permlane32_swap(__float_as_uint(ps), __float_as_uint(ps), false, false);
      ps = __uint_as_float(rr[0]) + __uint_as_float(rr[1]); }
    l_reg = l_reg * alpha + ps;
#define PK4(P, B_, OUT) do { unsigned a0 = cvtpk(P[B_+0], P[B_+1]), a1 = cvtpk(P[B_+2], P[B_+3]);                          \
        unsigned b0 = cvtpk(P[B_+4], P[B_+5]), b1 = cvtpk(P[B_+6], P[B_+7]);                                             \
        auto r0 = __builtin_amdgcn_permlane32_swap(a0, b0, false, false); auto r1 = __builtin_amdgcn_permlane32_swap(a1, b1, false, false); \
        v4u w = {r0[0], r1[0], r0[1], r1[1]}; OUT = *reinterpret_cast<bf16x8*>(&w); } while (0)
    PK4(p0, 0, pa0); PK4(p0, 8, pa1); PK4(p1, 0, pa2); PK4(p1, 8, pa3);
#undef PK4
}
template <int KB>
__device__ __forceinline__ void qkt(f32x16& p0, f32x16& p1, const char* K_lds, int r32, int hi, const bf16x8* qr) {
    p0 = f32x16{}; p1 = f32x16{};
    const char* kb[4];
#pragma unroll
    for (int dd = 0; dd < 4; ++dd) kb[dd] = K_lds + KB * SHM_K + KSWZ(r32, (dd * 16 + hi * 8) * 2);
#pragma unroll
    for (int d0 = 0; d0 < 8; ++d0) { const char* a = kb[d0 & 3] + (d0 >> 2) * 128;
        bf16x8 b0 = *reinterpret_cast<const bf16x8*>(a);
        bf16x8 b1 = *reinterpret_cast<const bf16x8*>(a + 32 * 256);
        p0 = __builtin_amdgcn_mfma_f32_32x32x16_bf16(b0, qr[d0], p0, 0, 0, 0);
        p1 = __builtin_amdgcn_mfma_f32_32x32x16_bf16(b1, qr[d0], p1, 0, 0, 0); }
}
template <int VB>
__device__ __forceinline__ void pv_tile(f32x16* o, int vb0, bf16x8 pa0, bf16x8 pa1, bf16x8 pa2, bf16x8 pa3) {
#define TRRD(dst, off) asm volatile("ds_read_b64_tr_b16 %0, %1 offset:%2" : "=&v"(dst) : "v"(vb0), "i"(off) : "memory")
#define PV_D0(d0) do { s16x4 l0, l1, l2, l3, h0, h1, h2, h3; constexpr int b_ = VB * SHM_V + v_rd_off(d0, 0, 0); \
        TRRD(l0, b_); TRRD(h0, b_ + 2048); TRRD(l1, b_ + 4096); TRRD(h1, b_ + 6144); TRRD(l2, b_ + 8192); TRRD(h2, b_ + 10240); TRRD(l3, b_ + 12288); TRRD(h3, b_ + 14336); \
        asm volatile("s_waitcnt lgkmcnt(0)" ::: "memory"); SBAR(); \
        o[d0] = __builtin_amdgcn_mfma_f32_32x32x16_bf16(pa0, (bf16x8){l0[0], l0[1], l0[2], l0[3], h0[0], h0[1], h0[2], h0[3]}, o[d0], 0, 0, 0);   \
        o[d0] = __builtin_amdgcn_mfma_f32_32x32x16_bf16(pa1, (bf16x8){l1[0], l1[1], l1[2], l1[3], h1[0], h1[1], h1[2], h1[3]}, o[d0], 0, 0, 0);   \
        o[d0] = __builtin_amdgcn_mfma_f32_32x32x16_bf16(pa2, (bf16x8){l2[0], l2[1], l2[2], l2[3], h2[0], h2[1], h2[2], h2[3]}, o[d0], 0, 0, 0);   \
        o[d0] = __builtin_amdgcn_mfma_f32_32x32x16_bf16(pa3, (bf16x8){l3[0], l3[1], l3[2], l3[3], h3[0], h3[1], h3[2], h3[3]}, o[d0], 0, 0, 0); } while (0)
    PV_D0(0); PV_D0(1); PV_D0(2); PV_D0(3);
#undef PV_D0
#undef TRRD
}
struct BlockRef { const bf16* Q; const bf16* K; const bf16* V; bf16* O; const u64* Mk; int P0; };
struct Seam { bf16x8 qr[8]; bf16x8 st_v0, st_v1, st_k0, st_k1; };
#define ROW(p, k0, rr) ((p) + (size_t)((k0) + (rr)) * D + sc)
#define VMW() asm volatile("s_waitcnt vmcnt(0)" ::: "memory")
#define VMWN(n) asm volatile("s_waitcnt vmcnt(%0)" :: "i"(n) : "memory")
#define SLOAD_H(Kp, Vp, k0) do { S.st_v0 = load8(ROW(Vp, k0, sr)); S.st_v1 = load8(ROW(Vp, k0, 32 + sr)); S.st_k0 = load8(ROW(Kp, k0, sr)); S.st_k1 = load8(ROW(Kp, k0, 32 + sr)); } while (0)
#define SWRITE_HK(bf) do { *(bf16x8*)(K_lds + (bf) * SHM_K + kws) = S.st_k0; *(bf16x8*)(K_lds + (bf) * SHM_K + kws + 32 * 256) = S.st_k1; } while (0)
#define SWRITE_HV(bf) do { *(bf16x8*)(V_lds + (bf) * SHM_V + vst0) = S.st_v0; *(bf16x8*)(V_lds + (bf) * SHM_V + vst1) = S.st_v1; } while (0)
#define SWRITE_H(bf) do { SWRITE_HV(bf); SWRITE_HK(bf); } while (0)
__device__ __forceinline__ void prime(const BlockRef& cur, char* lds, Seam& S) {
    const int tid = opaque_tid(), wid = __builtin_amdgcn_readfirstlane(tid >> 6), lane = tid & 63, r32 = lane & 31, hi = lane >> 5;
    const int sr = tid >> 4, sc = (tid & 15) * 8, kws = KSWZ(sr, sc * 2); char* K_lds = lds + 2 * SHM_V;
    for (int d0 = 0; d0 < 8; ++d0) S.qr[d0] = load8(cur.Q + (size_t)(wid * QBLK + r32) * D + d0 * 16 + hi * 8);
    SLOAD_H(cur.K, cur.V, 0); VMW(); SWRITE_HK(0);
    __syncthreads();
}
__device__ __forceinline__ void block(const BlockRef& cur, const BlockRef& nxt, char* lds, Seam& S) {
    const int tid = opaque_tid(), wid = __builtin_amdgcn_readfirstlane(tid >> 6), lane = tid & 63, r32 = lane & 31, hi = lane >> 5;
    const int NT = (cur.P0 + QB) / KVBLK;
    char* V_lds = lds; char* K_lds = lds + 2 * SHM_V;
    float* ws = (float*)(lds + 2 * SHM_V + 2 * SHM_K) + wid * 64; float* li_l = ws, * al_l = ws + 32;
    float m_reg = -1e30f, l_reg = 0; f32x16 o[4] = {};
    const int sr = tid >> 4, sc = (tid & 15) * 8, vst0 = v_st(sr, sc), vst1 = v_st(32 + sr, sc), kws = KSWZ(sr, sc * 2);
    const int vb0 = (int)(uintptr_t)V_lds + v_rd_base(lane);
    const bf16* Kh = cur.K; const bf16* Vh = cur.V;
    const u64* mk = cur.Mk + wid * QBLK + r32;
#define RESC(a) do { if (__any((a) < 1.f)) { if (hi == 0) al_l[r32] = (a); asm volatile("s_waitcnt lgkmcnt(0)" ::: "memory");              \
                     for (int d_ = 0; d_ < 4; ++d_) for (int r = 0; r < 16; ++r) o[d_][r] *= al_l[crow(r, hi)]; } } while (0)
#define KBASE(t) ((t) * KVBLK)
#define SEAM_K0() do { VMWN(8); SWRITE_HK(0); SBAR(); } while (0)
    f32x16 pA0, pA1, pB0, pB1; float mnA, mnB, alA, alB; bf16x8 pa0, pa1, pa2, pa3; u64 mw;
    SWRITE_HV(0); SBAR();
    mw = mk[0];
    if (NT > 1) SLOAD_H(Kh, Vh, KBASE(1));
    SBAR(); qkt<0>(pA0, pA1, K_lds, r32, hi, S.qr);
    mask_bits(pA0, pA1, mw, hi); partialSM(pA0, pA1, m_reg, mnA, alA);
    if (NT > 1) { VMW(); SWRITE_H(1); }
    __syncthreads();
#define HALF_STEP(PX0, PX1, mnX, alX, PY0, PY1, alY, t, KB, VB, SB) do {                                                      \
        SBAR(); mw = mk[(size_t)(t) * SEQ]; qkt<KB>(PX0, PX1, K_lds, r32, hi, S.qr);                                          \
        finishSM(PY0, PY1, alY, l_reg, pa0, pa1, pa2, pa3); SBAR();                                                           \
        if ((t) + 1 < NT) { SLOAD_H(Kh, Vh, KBASE((t) + 1)); SBAR(); }                                                        \
        pv_tile<VB>(o, vb0, pa0, pa1, pa2, pa3); mask_bits(PX0, PX1, mw, hi); partialSM(PX0, PX1, m_reg, mnX, alX);         \
        __syncthreads();                                                                                                      \
        if ((t) + 1 < NT) { VMW(); SWRITE_H(SB); }                                                                            \
        RESC(alX); __syncthreads(); } while (0)
    for (int t = 1; t + 1 < NT; t += 2) {
        HALF_STEP(pB0, pB1, mnB, alB, pA0, pA1, alA, t, 1, 0, 0);
        HALF_STEP(pA0, pA1, mnA, alA, pB0, pB1, alB, t + 1, 0, 1, 1);
    }
    mw = mk[(size_t)(NT - 1) * SEQ];
    SBAR(); qkt<1>(pB0, pB1, K_lds, r32, hi, S.qr); SBAR();
    SLOAD_H(nxt.K, nxt.V, 0); SBAR();
#pragma unroll
    for (int d0 = 0; d0 < 8; ++d0) S.qr[d0] = load8(nxt.Q + (size_t)(wid * QBLK + r32) * D + d0 * 16 + hi * 8);
    SBAR();
    finishSM(pA0, pA1, alA, l_reg, pa0, pa1, pa2, pa3); SBAR();
    pv_tile<0>(o, vb0, pa0, pa1, pa2, pa3);
    mask_bits(pB0, pB1, mw, hi); partialSM(pB0, pB1, m_reg, mnB, alB); __syncthreads(); RESC(alB);
    finishSM(pB0, pB1, alB, l_reg, pa0, pa1, pa2, pa3); SBAR(); pv_tile<1>(o, vb0, pa0, pa1, pa2, pa3);
    SBAR(); SEAM_K0();
    if (hi == 0) li_l[r32] = l_reg; asm volatile("s_waitcnt lgkmcnt(0)" ::: "memory");
    float rli[16];
#pragma unroll
    for (int r = 0; r < 16; ++r) rli[r] = __builtin_amdgcn_rcpf(li_l[crow(r, hi)]);
    bf16* Ow = cur.O + (size_t)(wid * QBLK) * LDO;
#pragma unroll
    for (int r = 0; r < 16; ++r) { const int orow = crow(r, hi);
#pragma unroll
        for (int d0 = 0; d0 < 4; ++d0) { const float v = o[d0][r] * rli[r];
            const float vn = __shfl_xor(v, 1);
            if ((r32 & 1) == 0) *(unsigned*)(Ow + (size_t)orow * LDO + d0 * 32 + r32) = cvtpk(v, vn); } }
    __syncthreads();
#undef RESC
#undef KBASE
#undef SEAM_K0
#undef HALF_STEP
}
#undef ROW
#undef VMW
#undef VMWN
#undef SLOAD_H
#undef SWRITE_HK
#undef SWRITE_HV
#undef SWRITE_H
#undef KSWZ
#undef SBAR
__device__ __forceinline__ BlockRef make_ref(const Args& a, int bh, int qb) {
    unsigned char* Dp = a.ws + WS_D; BlockRef r; const int b = bh >> 2, h = bh & 3; const size_t hb = (size_t)bh * SEQ;
    r.Q = (const bf16*)(Dp + D_AQ) + (hb + (size_t)qb * QB) * D; r.K = (const bf16*)(Dp + D_AK) + hb * D; r.V = (const bf16*)(Dp + D_AV) + hb * D;
    r.O = (bf16*)(a.ws + WS_B) + ((size_t)b * SEQ + (size_t)qb * QB) * LDO + 512 + h * 128;
    r.Mk = (const u64*)((const unsigned char*)a.out + O_MASK) + (size_t)b * 32 * SEQ + qb * QB; r.P0 = qb * QB;
    return r;
}
__device__ __forceinline__ void phase(unsigned char* lds_generic, const Args& a, int blk, int nblk) {
    char* lds = (char*)lds_generic;
    constexpr int NITEM = BATCH * 4 * 4;
    int L = blk; if (L >= NITEM) return;
    int pass = 0; BlockRef cur = make_ref(a, L >> 2, L & 3);
    Seam S; prime(cur, lds, S);
    for (;;) {
        const bool more_pass = pass == 0, more_item = L + nblk < NITEM, last = !more_pass && !more_item;
        int Ln = L, passn = pass + 1; if (!more_pass) { passn = 0; Ln = more_item ? L + nblk : L; }
        const int x = Ln & 3; const BlockRef nxt = last ? cur : make_ref(a, Ln >> 2, passn ? 7 - x : x);
        block(cur, nxt, lds, S);
        if (last) break;
        cur = nxt; pass = passn; L = Ln;
    }
}
}
__global__ void __launch_bounds__(256) k_convert_w(Args a) {
    __shared__ float scr[4][64 * 33];
    const int lane = threadIdx.x & 63, wave = threadIdx.x >> 6;
    convert_weights(a, a.layer, blockIdx.x * 4 + wave, gridDim.x * 4, (LAS float*)scr[wave], lane);
}
__global__ void __launch_bounds__(256) k_convert_x(Args a) { convert_x_and_rope(a, blockIdx.x * 256 + threadIdx.x, gridDim.x * 256); }
__global__ void __launch_bounds__(256) k_ln(Args a) {
    const int lane = threadIdx.x & 63, gw = blockIdx.x * 4 + (threadIdx.x >> 6), ngw = gridDim.x * 4;
    if (a.ph_lo == 0) ln_rows(a.out, (const float*)a.in[5] + a.layer * DM, (const float*)a.in[6] + a.layer * DM, a.out, (bf16*)(a.ws + WS_D + D_X1B), gw, ngw, lane);
    else if (a.layer + 1 < DEPTH) ln_rows(a.out, (const float*)a.in[9] + a.layer * DM, (const float*)a.in[10] + a.layer * DM, (float*)(a.ws + WS_C), (bf16*)(a.ws + WS_B), gw, ngw, lane);
    else ln_rows(a.out, (const float*)a.in[9] + a.layer * DM, (const float*)a.in[10] + a.layer * DM, a.out, nullptr, gw, ngw, lane);
}
__global__ void __launch_bounds__(512, 2) k_gemm(Args a) {
    extern __shared__ __attribute__((aligned(16))) unsigned char lds[];
    PG8_LAS unsigned char* L = (PG8_LAS unsigned char*)lds;
    unsigned char* ws = a.ws; unsigned char* D = ws + WS_D;
    const float* xres = a.layer == 0 ? (const float*)a.in[0] : (const float*)(ws + WS_C);
    pg8::StaticOrder S;
    if (a.ph_lo == 1) {
        pg8::Gemm g{(const bf16*)(ws + WS_B), (const bf16*)(ws + WS_WIN), M, IN_POS, DM}; S.init(M, IN_POS, gridDim.x, blockIdx.x);
        pg8::EpiProj E{D, (const float*)(ws + WS_R128), (const float*)(ws + WS_R64)};
        static_assert(pg8::EpiProj::O_RK == D_RK && pg8::EpiProj::O_RV == D_RV && pg8::EpiProj::O_RG == D_RG && pg8::EpiProj::O_AQ == D_AQ && pg8::EpiProj::O_AK == D_AK && pg8::EpiProj::O_AV == D_AV && pg8::EpiProj::O_IQ == D_IQ && pg8::EpiProj::O_IK == D_IK && pg8::EpiProj::O_IW == D_IW, "projection map");
        pg8::gemm_phase<pg8::EpiProj, pg8::StaticOrder, true, true>(L, g, S, E);
    } else if (a.ph_lo == 2) {
        pg8::Gemm g{(const bf16*)(ws + WS_B), (const bf16*)(ws + WS_WOUT), M, DM, DM}; S.init(M, DM, gridDim.x, blockIdx.x);
        pg8::EpiRes E{xres, a.out, DN_ALPHA};
        pg8::gemm_phase<pg8::EpiRes, pg8::StaticOrder, true, true>(L, g, S, E);
    } else if (a.ph_lo == 3) {
        pg8::Gemm g{(const bf16*)(D + D_X1B), (const bf16*)(ws + WS_WGU), M, 2 * FFN, DM}; S.init(M, 2 * FFN, gridDim.x, blockIdx.x);
        pg8::EpiSwiGLU E{(bf16*)(D + D_H)};
        pg8::gemm_phase<pg8::EpiSwiGLU, pg8::StaticOrder, true, true>(L, g, S, E);
    } else {
        pg8::Gemm g{(const bf16*)(D + D_H), (const bf16*)(ws + WS_WDN), M, DM, FFN}; S.init(M, DM, gridDim.x, blockIdx.x);
        pg8::EpiRes E{a.out, a.out, DN_ALPHA};
        pg8::gemm_phase<pg8::EpiRes, pg8::StaticOrder, true, true>(L, g, S, E);
    }
}

#ifndef FAST_RET
#define FAST_RET 1
#endif
#ifndef FAST_IDX
#define FAST_IDX 1
#endif
#ifndef FAST_ATT
#define FAST_ATT 1
#endif
constexpr int LDS_BYTES = 147456;
__global__ void __launch_bounds__(512, 2) k_fast(Args a) {
    extern __shared__ __attribute__((aligned(16))) unsigned char lds[];
    LAS unsigned char* L = (LAS unsigned char*)lds;
    if (a.ph_lo == 20) ret_kv_phase(L, a, blockIdx.x, gridDim.x);
    else if (a.ph_lo == 21) idx_phase(L, a, blockIdx.x, gridDim.x);
    else if (a.ph_lo == 30) ret_out_phase(L, a, blockIdx.x, gridDim.x);
    else att::phase(lds, a, blockIdx.x, gridDim.x);
}
__device__ __forceinline__ float block_sum128(float v, float* red) {
    v = wave_sum(v); __syncthreads(); if ((threadIdx.x & 63) == 0) red[threadIdx.x >> 6] = v; __syncthreads(); return red[0] + red[1];
}
__global__ void __launch_bounds__(128) k_naive_ret(Args a) {
    __shared__ float sq[128], sk[128], red[2];
    unsigned char* D = a.ws + WS_D; const bf16* rq = (const bf16*)(D + D_RQ); const bf16* rk = (const bf16*)(D + D_RK); const bf16* rv = (const bf16*)(D + D_RV); const bf16* rg = (const bf16*)(D + D_RG);
    bf16* mix = (bf16*)(a.ws + WS_B); const float* gain = (const float*)a.in[3] + a.layer * 512;
    const int b = blockIdx.x >> 2, h = blockIdx.x & 3, e = threadIdx.x;
    const float gamma = 1.0f - exp2f(-5.0f - (float)h); const float gn = gain[h * 128 + e];
    float S[128];
#pragma unroll
    for (int d = 0; d < 128; ++d) S[d] = 0.f;
    for (int t = 0; t < SEQ; ++t) {
        const size_t row = (size_t)b * SEQ + t;
        sq[e] = bf2f(rq[row * 512 + h * 128 + e]); sk[e] = bf2f(rk[row * 512 + h * 128 + e]); const float v = bf2f(rv[row * 512 + h * 128 + e]);
        __syncthreads();
        float o = 0.f;
#pragma unroll
        for (int d = 0; d < 128; ++d) { S[d] = gamma * S[d] + sk[d] * v; o += sq[d] * S[d]; }
        const float mean = block_sum128(o, red) * (1.f / 128.f); const float dv = o - mean;
        const float var = block_sum128(dv * dv, red) * (1.f / 128.f);
        const float y = dv * (1.0f / sqrtf(var + LN_EPS)) * gn * bf2f(rg[row * 512 + h * 128 + e]);
        mix[row * 1024 + h * 128 + e] = (bf16)f2bf(y);
        __syncthreads();
    }
}
__global__ void __launch_bounds__(256) k_naive_idx(Args a) {
    __shared__ float sq[512]; __shared__ float sw[8]; __shared__ unsigned keys[SEQ]; __shared__ int cnt[4];
    unsigned char* D = a.ws + WS_D; const bf16* iq = (const bf16*)(D + D_IQ); const bf16* ik = (const bf16*)(D + D_IK); const float* iw = (const float*)(D + D_IW);
    u64* mask = (u64*)((unsigned char*)a.out + O_MASK);
    const int t = blockIdx.x, b = blockIdx.y, tid = threadIdx.x, lane = tid & 63, wave = tid >> 6; const size_t row = (size_t)b * SEQ + t;
    sq[tid] = bf2f(iq[row * 512 + tid]); sq[tid + 256] = bf2f(iq[row * 512 + 256 + tid]); if (tid < 8) sw[tid] = iw[row * 8 + tid];
    __syncthreads();
    unsigned key[8];
#pragma unroll
    for (int k = 0; k < 8; ++k) { const int s = tid + 256 * k; key[k] = 0u;
        if (s <= t) { float kf[64]; const bf16* kr = ik + ((size_t)b * SEQ + s) * 64;
#pragma unroll
            for (int d = 0; d < 64; ++d) kf[d] = bf2f(kr[d]);
            float sc = 0.f;
#pragma unroll
            for (int h = 0; h < 8; ++h) { float dot = 0.f;
#pragma unroll
                for (int d = 0; d < 64; ++d) dot += sq[h * 64 + d] * kf[d];
                sc += sw[h] * fmaxf(dot, 0.f); }
            key[k] = okey(sc + 0.0f); }
        keys[s] = key[k]; }
    __syncthreads();
    bool sel[8];
    if (t < TOPK) {
#pragma unroll
        for (int k = 0; k < 8; ++k) sel[k] = (tid + 256 * k) <= t;
    } else {
        unsigned thr = 0u;
        for (int bit = 31; bit >= 0; --bit) { const unsigned cand = thr | (1u << bit); int c = 0;
#pragma unroll
            for (int k = 0; k < 8; ++k) c += __popcll(__ballot(key[k] >= cand));
            __syncthreads(); if (lane == 0) cnt[wave] = c; __syncthreads();
            if (cnt[0] + cnt[1] + cnt[2] + cnt[3] >= TOPK) thr = cand; }
        int c = 0;
#pragma unroll
        for (int k = 0; k < 8; ++k) c += __popcll(__ballot(key[k] > thr));
        __syncthreads(); if (lane == 0) cnt[wave] = c; __syncthreads();
        const int need = TOPK - (cnt[0] + cnt[1] + cnt[2] + cnt[3]);
#pragma unroll
        for (int k = 0; k < 8; ++k) { const int s = tid + 256 * k; sel[k] = key[k] > thr;
            if (key[k] == thr) { int rank = 0; for (int s2 = 0; s2 < s; ++s2) rank += (keys[s2] == thr) ? 1 : 0; sel[k] = rank < need; } }
    }
#pragma unroll
    for (int k = 0; k < 8; ++k) { const u64 w = __ballot(sel[k]); if (lane == 0) mask[((size_t)b * 32 + 4 * k + wave) * SEQ + t] = w; }
}
__global__ void __launch_bounds__(256) k_naive_att(Args a) {
    __shared__ float sp[4][SEQ]; __shared__ float sqv[4][128];
    unsigned char* D = a.ws + WS_D; const bf16* aq = (const bf16*)(D + D_AQ); const bf16* ak = (const bf16*)(D + D_AK); const bf16* av = (const bf16*)(D + D_AV);
    const u64* mask = (const u64*)((const unsigned char*)a.out + O_MASK); bf16* mix = (bf16*)(a.ws + WS_B);
    const int t = blockIdx.x, b = blockIdx.y, lane = threadIdx.x & 63, h = threadIdx.x >> 6; const size_t hb = ((size_t)b * 4 + h) * SEQ;
    sqv[h][lane] = bf2f(aq[(hb + t) * 128 + lane]); sqv[h][lane + 64] = bf2f(aq[(hb + t) * 128 + 64 + lane]);
    __syncthreads();
    float mx = -INFINITY;
    for (int j = 0; j <= t / 64; ++j) { const u64 w = mask[((size_t)b * 32 + j) * SEQ + t]; const int s = 64 * j + lane; float sc = -INFINITY;
        if ((w >> lane) & 1ull) { const bf16* kr = ak + (hb + s) * 128; float dot = 0.f;
            for (int d = 0; d < 128; ++d) dot += sqv[h][d] * bf2f(kr[d]);
            sc = dot * 0.08838834764831845f; }
        sp[h][s] = sc; mx = fmaxf(mx, sc); }
#pragma unroll
    for (int o = 1; o < 64; o <<= 1) mx = fmaxf(mx, __shfl_xor(mx, o));
    __syncthreads();
    float l = 0.f, o0 = 0.f, o1 = 0.f;
    for (int s = 0; s < 64 * (t / 64 + 1); ++s) { const float sc = sp[h][s]; if (sc == -INFINITY) continue;
        const float p = __expf(sc - mx); l += p; const bf16* vr = av + (hb + s) * 128; o0 += p * bf2f(vr[lane]); o1 += p * bf2f(vr[64 + lane]); }
    const float il = 1.0f / l; const size_t row = (size_t)b * SEQ + t;
    mix[row * 1024 + 512 + h * 128 + lane] = (bf16)f2bf(o0 * il); mix[row * 1024 + 512 + h * 128 + 64 + lane] = (bf16)f2bf(o1 * il);
}


#ifndef MEGA
#define MEGA 1
#endif
__global__ void __launch_bounds__(512, 2) k_mega(Args a0) {
    extern __shared__ __attribute__((aligned(16))) unsigned char lds[];
    LAS unsigned char* L = (LAS unsigned char*)lds; PG8_LAS unsigned char* LG = (PG8_LAS unsigned char*)lds;
    cg::grid_group grid = cg::this_grid();
    const int blk = blockIdx.x, G = gridDim.x;
#define TIDS() const int tid = opaque_tid(), lane = tid & 63, wave = __builtin_amdgcn_readfirstlane(tid >> 6), gw = blk * 8 + wave, ngw = G * 8; (void)lane; (void)gw; (void)ngw
#define BAR() grid.sync()
    Args a = a0; a.layer = 0;
    unsigned char* ws = a.ws; unsigned char* D = ws + WS_D;
    { TIDS(); convert_weights(a, 0, gw, ngw, (LAS float*)(L + wave * 8448), lane); convert_x_and_rope(a, blk * 512 + tid, G * 512); }
    BAR();
    for (int layer = 0; layer < DEPTH; ++layer) {
        a.layer = layer;
        const float* xres = layer == 0 ? (const float*)a.in[0] : (const float*)(ws + WS_C);
        pg8::StaticOrder S;
        {
            pg8::Gemm g{(const bf16*)(ws + WS_B), (const bf16*)(ws + WS_WIN), M, IN_POS, DM}; S.init(M, IN_POS, G, blk);
            pg8::EpiProj E{D, (const float*)(ws + WS_R128), (const float*)(ws + WS_R64)};
            pg8::gemm_phase<pg8::EpiProj, pg8::StaticOrder, true, true>(LG, g, S, E);
        }
        BAR();
        ret_kv_phase(L, a, blk, G); idx_phase(L, a, blk, G);
        BAR();
        att::phase(lds, a, blk, G); ret_out_phase(L, a, blk, G);
        BAR();
        {
            pg8::Gemm g{(const bf16*)(ws + WS_B), (const bf16*)(ws + WS_WOUT), M, DM, DM}; S.init(M, DM, G, blk);
            pg8::EpiRes E{xres, a.out, DN_ALPHA};
            pg8::gemm_phase<pg8::EpiRes, pg8::StaticOrder, true, true>(LG, g, S, E);
        }
        BAR();
        { TIDS(); ln_rows(a.out, (const float*)a.in[5] + layer * DM, (const float*)a.in[6] + layer * DM, a.out, (bf16*)(D + D_X1B), gw, ngw, lane); }
        BAR();
        {
            pg8::Gemm g{(const bf16*)(D + D_X1B), (const bf16*)(ws + WS_WGU), M, 2 * FFN, DM}; S.init(M, 2 * FFN, G, blk);
            pg8::EpiSwiGLU E{(bf16*)(D + D_H)};
            pg8::gemm_phase<pg8::EpiSwiGLU, pg8::StaticOrder, true, true>(LG, g, S, E);
        }
        BAR();
        {
            pg8::Gemm g{(const bf16*)(D + D_H), (const bf16*)(ws + WS_WDN), M, DM, FFN}; S.init(M, DM, G, blk);
            pg8::EpiRes E{a.out, a.out, DN_ALPHA};
            pg8::gemm_phase<pg8::EpiRes, pg8::StaticOrder, true, true>(LG, g, S, E);
        }
        BAR();
        if (layer + 1 < DEPTH) {
            TIDS(); ln_rows(a.out, (const float*)a.in[9] + layer * DM, (const float*)a.in[10] + layer * DM, (float*)(ws + WS_C), (bf16*)(ws + WS_B), gw, ngw, lane);
            convert_weights(a, layer + 1, gw, ngw, (LAS float*)(L + wave * 8448), lane);
            BAR();
        } else {
            TIDS(); ln_rows(a.out, (const float*)a.in[9] + layer * DM, (const float*)a.in[10] + layer * DM, a.out, nullptr, gw, ngw, lane);
        }
    }
#undef BAR
}

extern "C" void kernel_launch(void* const* d_in, const int* in_sizes, int n_in, void* d_out, int out_size, void* d_ws, size_t ws_size, hipStream_t stream) {
    static int init = 0;
    if (!init) { init = 1;
        if (n_in != 11 || out_size != M * DM || ws_size < WS_END) fprintf(stderr, "kernel_launch: unexpected shapes: n_in %d out %d ws %zu (need >= %zu)\n", n_in, out_size, ws_size, (size_t)WS_END);
        (void)hipFuncSetAttribute((const void*)k_gemm, hipFuncAttributeMaxDynamicSharedMemorySize, 131072);
        (void)hipFuncSetAttribute((const void*)k_fast, hipFuncAttributeMaxDynamicSharedMemorySize, LDS_BYTES);
    }
    Args a{}; for (int i = 0; i < 11; ++i) a.in[i] = d_in[i]; a.out = (float*)d_out; a.ws = (unsigned char*)d_ws;
#if MEGA
    static int grid = 0;
    if (!grid) {
        int dev = 0, cus = 0, per_cu = 0; (void)hipGetDevice(&dev); (void)hipDeviceGetAttribute(&cus, hipDeviceAttributeMultiprocessorCount, dev);
        (void)hipFuncSetAttribute((const void*)k_mega, hipFuncAttributeMaxDynamicSharedMemorySize, LDS_BYTES);
        if (hipOccupancyMaxActiveBlocksPerMultiprocessor(&per_cu, (const void*)k_mega, 512, LDS_BYTES) != hipSuccess || per_cu < 1) { fprintf(stderr, "kernel_launch: occupancy query says %d blocks per CU\n", per_cu); per_cu = 1; }
        grid = cus * 1;
        if (grid <= 0) grid = 256;
    }
    { void* args[] = {&a}; const hipError_t e = hipLaunchCooperativeKernel((void*)k_mega, dim3(grid), dim3(512), args, LDS_BYTES, stream);
      if (e != hipSuccess) fprintf(stderr, "kernel_launch: cooperative launch failed: %s (grid %d)\n", hipGetErrorString(e), grid); }
    return;
#endif
    hipLaunchKernelGGL(k_convert_x, dim3(2048), dim3(256), 0, stream, a);
    for (int layer = 0; layer < DEPTH; ++layer) {
        a.layer = layer; a.ph_lo = 0; a.ph_hi = 0;
        hipLaunchKernelGGL(k_convert_w, dim3(1024), dim3(256), 0, stream, a);
        a.ph_lo = 1; hipLaunchKernelGGL(k_gemm, dim3(256), dim3(512), 131072, stream, a);
#if FAST_RET
        a.ph_lo = 20; hipLaunchKernelGGL(k_fast, dim3(256), dim3(512), LDS_BYTES, stream, a);
        a.ph_lo = 30; hipLaunchKernelGGL(k_fast, dim3(256), dim3(512), LDS_BYTES, stream, a);
#else
        hipLaunchKernelGGL(k_naive_ret, dim3(64), dim3(128), 0, stream, a);
#endif
#if FAST_IDX
        a.ph_lo = 21; hipLaunchKernelGGL(k_fast, dim3(256), dim3(512), LDS_BYTES, stream, a);
#else
        hipLaunchKernelGGL(k_naive_idx, dim3(SEQ, BATCH), dim3(256), 0, stream, a);
#endif
#if FAST_ATT
        a.ph_lo = 31; hipLaunchKernelGGL(k_fast, dim3(256), dim3(512), LDS_BYTES, stream, a);
#else
        hipLaunchKernelGGL(k_naive_att, dim3(SEQ, BATCH), dim3(256), 0, stream, a);
#endif
        a.ph_lo = 2; hipLaunchKernelGGL(k_gemm, dim3(256), dim3(512), 131072, stream, a);
        a.ph_lo = 0; hipLaunchKernelGGL(k_ln, dim3(2048), dim3(256), 0, stream, a);
        a.ph_lo = 3; hipLaunchKernelGGL(k_gemm, dim3(256), dim3(512), 131072, stream, a);
        a.ph_lo = 4; hipLaunchKernelGGL(k_gemm, dim3(256), dim3(512), 131072, stream, a);
        a.ph_lo = 1; hipLaunchKernelGGL(k_ln, dim3(2048), dim3(256), 0, stream, a);
    }
}
```

```cpp
#include <hip/hip_runtime.h>
#include <hip/hip_cooperative_groups.h>
#include <cstdio>
#include <cstdint>
namespace cg = cooperative_groups;
template <class T> __device__ __forceinline__ T* opq(T* p) { asm volatile("" : "+s"(p)); return p; }
__device__ __forceinline__ int opaque_tid() { int t = threadIdx.x; asm volatile("" : "+v"(t)); return t; }

namespace pg8 {
#define PG8_LAS __attribute__((address_space(3)))
typedef unsigned short bf16_t;
typedef short bf16x8 __attribute__((ext_vector_type(8)));
typedef float f32x4 __attribute__((ext_vector_type(4)));
typedef unsigned u32x4 __attribute__((ext_vector_type(4)));
constexpr int BM = 256, BK = 64, HALF = 128, HTB = HALF * BK * 2  , STAGE_BYTES = 8 * HTB, NXCD = 8, WGM = 8;

__host__ __device__ __forceinline__ int lds_byte(int r, int c) { const int st = (r >> 4) * 2 + (c >> 5), rr = r & 15, cc = c & 31, ob = rr * 64 + cc * 2; return st * 1024 + (ob ^ (((ob >> 9) & 1) << 5)); }
__host__ __device__ __forceinline__ void stage_rc(int b, int& R, int& C) { const int st = b / 1024, sb = b % 1024, swz = sb ^ (((sb >> 9) & 1) << 5); R = (st >> 1) * 16 + swz / 64; C = (st & 1) * 32 + (swz % 64) / 2; }
__host__ __device__ __forceinline__ int perm32(int rho) { const int n = rho >> 4, i = rho & 15; return 8 * (i >> 2) + 4 * n + (i & 3); }

struct Unit { int pm, pn; };
struct Gemm { const bf16_t* A; const bf16_t* Bt; int M, N, K; };

struct StaticOrder {
    int nM, nN, nwg, G, c;
    __host__ __device__ void init(int M, int N, int G_, int c_) { nM = M / BM; nN = N / BM; nwg = nM * nN; G = G_; c = c_; }
    __host__ __device__ bool next(int i, Unit& u) const {
        const long L = (long)i * G + c; if (L >= nwg) return false;
        int wgid = (int)L; { const int q = nwg / NXCD, r = nwg % NXCD, xcd = wgid % NXCD, off = wgid / NXCD; wgid = (xcd < r ? xcd * (q + 1) : r * (q + 1) + (xcd - r) * q) + off; }
        const int nig = WGM * nN, gid = wgid / nig, fm = gid * WGM, gsz = (nM - fm) < WGM ? (nM - fm) : WGM;
        u.pm = fm + ((wgid % nig) % gsz); u.pn = (wgid % nig) / gsz; return true;
    }
    __device__ __forceinline__ void a_ready(const Unit&) const {}
    __device__ __forceinline__ void done(const Unit&) const {}
};

__device__ __forceinline__ unsigned cvt_pk_bf16(float lo, float hi) { unsigned r; asm volatile("v_cvt_pk_bf16_f32 %0, %1, %2" : "=v"(r) : "v"(lo), "v"(hi)); return r; }
typedef float f32x2 __attribute__((ext_vector_type(2)));

typedef unsigned u32x2 __attribute__((ext_vector_type(2)));
__device__ __forceinline__ float silu_f(float x) { return x * __builtin_amdgcn_rcpf(1.0f + __builtin_amdgcn_exp2f(-1.4426950408889634f * x)); }

struct EpiProj {
    static constexpr bool PERM = false, AFTER_DRAIN = false;
    unsigned char* D; const float* r128; const float* r64;
    static constexpr size_t MB = 1u << 20, O_RQ = 0, O_RK = 32 * MB, O_RV = 64 * MB, O_RG = 96 * MB, O_AQ = 128 * MB, O_AK = 160 * MB, O_AV = 192 * MB, O_IQ = 224 * MB, O_IK = 256 * MB, O_IW = 260 * MB;
    __device__ __forceinline__ void operator()(const f32x4 (&acc)[2][2][4][2], const Unit& u, int wr, int wc, int fr, int fq) const {
        const int pn = u.pn; const int rowb = u.pm * BM + wr * 64 + fr;
        if (pn < 4 || (pn >= 8 && pn < 12)) {
            const bool isatt = pn >= 8, isk = (pn & 2) != 0; const float sc = (!isatt && isk) ? 0.08838834764831845f : 1.0f;
            const int i0 = 16 * wc + 4 * fq;
#pragma unroll
            for (int ai = 0; ai < 2; ++ai)
#pragma unroll
                for (int m = 0; m < 4; ++m) {
                    const int row = rowb + ai * HALF + m * 16;
                    const f32x4 cs0 = *(const f32x4*)(r128 + ((size_t)row * 64 + i0) * 2), cs1 = *(const f32x4*)(r128 + ((size_t)row * 64 + i0) * 2 + 4);
                    const float c[4] = {cs0[0], cs0[2], cs1[0], cs1[2]}, s[4] = {cs0[1], cs0[3], cs1[1], cs1[3]};
#pragma unroll
                    for (int bj = 0; bj < 2; ++bj) {
                        const f32x4 x1 = acc[ai][bj][m][0], x2 = acc[ai][bj][m][1]; float o1[4], o2[4];
#pragma unroll
                        for (int j = 0; j < 4; ++j) { o1[j] = (x1[j] * c[j] - x2[j] * s[j]) * sc; o2[j] = (x1[j] * s[j] + x2[j] * c[j]) * sc; }
                        const int head = 2 * (pn & 1) + bj; bf16_t* dst;
                        if (!isatt) dst = (bf16_t*)(D + (isk ? O_RK : O_RQ)) + (size_t)row * 512 + head * 128;
                        else dst = (bf16_t*)(D + (isk ? O_AK : O_AQ)) + ((size_t)((row >> 11) * 4 + head) * 2048 + (row & 2047)) * 128;
                        u32x2 w1, w2; w1.x = cvt_pk_bf16(o1[0], o1[1]); w1.y = cvt_pk_bf16(o1[2], o1[3]); w2.x = cvt_pk_bf16(o2[0], o2[1]); w2.y = cvt_pk_bf16(o2[2], o2[3]);
                        *(u32x2*)(dst + i0) = w1; *(u32x2*)(dst + 64 + i0) = w2;
                    }
                }
        } else if (pn < 14) {
            const bool isg = (pn == 6 || pn == 7), isav = pn >= 12;
            bf16_t* base = (bf16_t*)(D + (isav ? O_AV : (isg ? O_RG : O_RV)));
#pragma unroll
            for (int ai = 0; ai < 2; ++ai)
#pragma unroll
                for (int m = 0; m < 4; ++m) {
                    const int row = rowb + ai * HALF + m * 16;
#pragma unroll
                    for (int bj = 0; bj < 2; ++bj) {
                        f32x4 v0 = acc[ai][bj][m][0], v1 = acc[ai][bj][m][1];
                        if (isg) {
#pragma unroll
                            for (int j = 0; j < 4; ++j) { v0[j] = silu_f(v0[j]); v1[j] = silu_f(v1[j]); }
                        }
                        const int col = (pn & 1) * 256 + bj * HALF + wc * 32 + 8 * fq;
                        bf16_t* dst = isav ? base + ((size_t)((row >> 11) * 4 + (col >> 7)) * 2048 + (row & 2047)) * 128 + (col & 127) : base + (size_t)row * 512 + col;
                        u32x4 w; w.x = cvt_pk_bf16(v0[0], v0[1]); w.y = cvt_pk_bf16(v0[2], v0[3]); w.z = cvt_pk_bf16(v1[0], v1[1]); w.w = cvt_pk_bf16(v1[2], v1[3]);
                        *(u32x4*)dst = w;
                    }
                }
        } else {
            const int i0 = 16 * (wc & 1) + 4 * fq;
#pragma unroll
            for (int ai = 0; ai < 2; ++ai)
#pragma unroll
                for (int m = 0; m < 4; ++m) {
                    const int row = rowb + ai * HALF + m * 16;
                    if (pn < 16 || wc < 2) {
                        const f32x4 cs0 = *(const f32x4*)(r64 + ((size_t)row * 32 + i0) * 2), cs1 = *(const f32x4*)(r64 + ((size_t)row * 32 + i0) * 2 + 4);
                        const float c[4] = {cs0[0], cs0[2], cs1[0], cs1[2]}, s[4] = {cs0[1], cs0[3], cs1[1], cs1[3]};
#pragma unroll
                        for (int bj = 0; bj < 2; ++bj) {
                            if (pn == 16 && bj == 1) continue;
                            const f32x4 x1 = acc[ai][bj][m][0], x2 = acc[ai][bj][m][1]; float o1[4], o2[4];
                            const float sc = pn < 16 ? 0.125f : 1.0f;
#pragma unroll
                            for (int j = 0; j < 4; ++j) { o1[j] = (x1[j] * c[j] - x2[j] * s[j]) * sc; o2[j] = (x1[j] * s[j] + x2[j] * c[j]) * sc; }
                            bf16_t* dst = pn < 16 ? (bf16_t*)(D + O_IQ) + (size_t)row * 512 + (4 * (pn - 14) + 2 * bj + (wc >> 1)) * 64 : (bf16_t*)(D + O_IK) + (size_t)row * 64;
                            u32x2 w1, w2; w1.x = cvt_pk_bf16(o1[0], o1[1]); w1.y = cvt_pk_bf16(o1[2], o1[3]); w2.x = cvt_pk_bf16(o2[0], o2[1]); w2.y = cvt_pk_bf16(o2[2], o2[3]);
                            *(u32x2*)(dst + i0) = w1; *(u32x2*)(dst + 32 + i0) = w2;
                        }
                    } else if (wc == 2 && fq < 2) {
                        *(f32x4*)((float*)(D + O_IW) + (size_t)row * 8 + 4 * fq) = acc[ai][0][m][0] * 0.35355339059327373f;
                    }
                }
        }
    }
};
struct EpiRes {
    static constexpr bool PERM = false, AFTER_DRAIN = false;
    const float* base; float* out; float alpha;
    __device__ __forceinline__ void operator()(const f32x4 (&acc)[2][2][4][2], const Unit& u, int wr, int wc, int fr, int fq) const {
        const int rowb = u.pm * BM + wr * 64 + fr, colb = u.pn * BM + wc * 32 + 4 * fq;
#pragma unroll
        for (int ai = 0; ai < 2; ++ai)
#pragma unroll
            for (int m = 0; m < 4; ++m) { const size_t off = (size_t)(rowb + ai * HALF + m * 16) * 1024 + colb;
#pragma unroll
                for (int bj = 0; bj < 2; ++bj)
#pragma unroll
                    for (int n = 0; n < 2; ++n) { const f32x4 b = *(const f32x4*)(base + off + bj * HALF + n * 16); *(f32x4*)(out + off + bj * HALF + n * 16) = b * alpha + acc[ai][bj][m][n]; } }
    }
};
struct EpiSwiGLU {
    static constexpr bool PERM = false, AFTER_DRAIN = false;
    bf16_t* h;
    __device__ __forceinline__ void operator()(const f32x4 (&acc)[2][2][4][2], const Unit& u, int wr, int wc, int fr, int fq) const {
        const int rowb = u.pm * BM + wr * 64 + fr, colb = u.pn * 128 + wc * 32 + 8 * fq;
#pragma unroll
        for (int ai = 0; ai < 2; ++ai)
#pragma unroll
            for (int m = 0; m < 4; ++m) {
                const f32x4 g0 = acc[ai][0][m][0], g1 = acc[ai][0][m][1], u0 = acc[ai][1][m][0], u1 = acc[ai][1][m][1]; float o[8];
#pragma unroll
                for (int j = 0; j < 4; ++j) { o[j] = silu_f(g0[j]) * u0[j]; o[4 + j] = silu_f(g1[j]) * u1[j]; }
                u32x4 w; w.x = cvt_pk_bf16(o[0], o[1]); w.y = cvt_pk_bf16(o[2], o[3]); w.z = cvt_pk_bf16(o[4], o[5]); w.w = cvt_pk_bf16(o[6], o[7]);
                *(u32x4*)(h + (size_t)(rowb + ai * HALF + m * 16) * 2816 + colb) = w;
            }
    }
};
template <class Epi, class Sched, bool ALIGN_EPI = false, bool SP2 = false>
__device__ __forceinline__ void gemm_phase(PG8_LAS unsigned char* lds, const Gemm g, const Sched& S, const Epi& E) {
    const int tid = opaque_tid(), wid = __builtin_amdgcn_readfirstlane(tid >> 6), lane = tid & 63, wr = wid >> 2, wc = wid & 3, fr = lane & 15, fq = lane >> 4;
    const int K = g.K, nt = K / BK;
    unsigned voffA[2], voffB[2];
#pragma unroll
    for (int i = 0; i < 2; ++i) { int R, C; stage_rc(tid * 16 + i * 8192, R, C); const int Rb = Epi::PERM ? ((R & ~31) + perm32(R & 31)) : R;
        voffA[i] = (unsigned)(R * K + C) * 2u; voffB[i] = (unsigned)(Rb * K + C) * 2u; }
    const size_t kstep = (size_t)(BK * 2);
    const size_t hstep = (size_t)HALF * K * 2;
    const size_t tstep = 2 * hstep;
    const unsigned ldsw = (unsigned)wid * 1024u;
    const int aoff = lds_byte(wr * 64 + fr, fq * 8), boff = lds_byte(wc * 32 + fr, fq * 8);
#define PG8_SA(b, h) (((b) * 2 + (h)) * HTB)
#define PG8_SB(b, h) ((4 + (b) * 2 + (h)) * HTB)
#define PG8_STAGE(bufoff, gbase, voff) do { _Pragma("unroll") for (int _i = 0; _i < 2; ++_i) \
        __builtin_amdgcn_global_load_lds((const unsigned*)((const char*)(gbase) + (voff)[_i]), (PG8_LAS unsigned*)(lds + (bufoff) + ldsw + _i * 8192), 16, 0, 0); } while (0)
#define PG8_LDA(dst, b, h) do { _Pragma("unroll") for (int m = 0; m < 4; ++m) _Pragma("unroll") for (int k = 0; k < 2; ++k) dst[m][k] = *(const PG8_LAS bf16x8*)(lds + PG8_SA(b, h) + aoff + m * 2048 + k * 1024); } while (0)
#define PG8_LDB(dst, b, h) do { _Pragma("unroll") for (int n = 0; n < 2; ++n) _Pragma("unroll") for (int k = 0; k < 2; ++k) dst[n][k] = *(const PG8_LAS bf16x8*)(lds + PG8_SB(b, h) + boff + n * 2048 + k * 1024); } while (0)
#define PG8_MMA(ai, bj, At, Bt) do { __builtin_amdgcn_s_setprio(1); _Pragma("unroll") for (int m = 0; m < 4; ++m) _Pragma("unroll") for (int n = 0; n < 2; ++n) _Pragma("unroll") for (int k = 0; k < 2; ++k) \
        acc[ai][bj][m][n] = __builtin_amdgcn_mfma_f32_16x16x32_bf16(Bt[n][k], At[m][k], acc[ai][bj][m][n], 0, 0, 0); __builtin_amdgcn_s_setprio(0); } while (0)
#define PG8_WAIT_V(n) asm volatile("s_waitcnt vmcnt(" #n ")" ::: "memory")
#define PG8_WAIT_L(n) asm volatile("s_waitcnt lgkmcnt(" #n ")" ::: "memory")
#define PG8_BAR __builtin_amdgcn_s_barrier()
#define PG8_SCHED __builtin_amdgcn_sched_barrier(0)
    Unit cur, nxt; int ui = 0;
    if (!S.next(0, cur)) return;
    f32x4 acc[2][2][4][2];
#pragma unroll
    for (int a = 0; a < 2; ++a)
#pragma unroll
        for (int b = 0; b < 2; ++b)
#pragma unroll
            for (int m = 0; m < 4; ++m)
#pragma unroll
                for (int n = 0; n < 2; ++n) acc[a][b][m][n] = (f32x4){0.f, 0.f, 0.f, 0.f};
    bf16x8 At[4][2], B0[2][2], B1[2][2];
    const char* cA = (const char*)g.A + (size_t)cur.pm * tstep; const char* cB = (const char*)g.Bt + (size_t)cur.pn * tstep;
    S.a_ready(cur);
    if constexpr (SP2) {
        PG8_STAGE(PG8_SB(0, 0), cB, voffB); PG8_STAGE(PG8_SB(0, 1), cB + hstep, voffB); PG8_STAGE(PG8_SA(0, 0), cA, voffA); PG8_STAGE(PG8_SA(0, 1), cA + hstep, voffA);
        if (wr == 1) PG8_BAR;
        PG8_WAIT_V(2); PG8_BAR;
        PG8_STAGE(PG8_SB(1, 0), cB + kstep, voffB); PG8_STAGE(PG8_SA(1, 0), cA + kstep, voffA); PG8_STAGE(PG8_SB(1, 1), cB + hstep + kstep, voffB);
        PG8_WAIT_V(6); PG8_BAR;
    } else {
        PG8_STAGE(PG8_SB(0, 0), cB, voffB); PG8_STAGE(PG8_SA(0, 0), cA, voffA); PG8_STAGE(PG8_SB(0, 1), cB + hstep, voffB); PG8_STAGE(PG8_SA(0, 1), cA + hstep, voffA);
        if (wr == 1) PG8_BAR;
        PG8_WAIT_V(4); PG8_BAR;
        PG8_STAGE(PG8_SB(1, 0), cB + kstep, voffB); PG8_STAGE(PG8_SA(1, 0), cA + kstep, voffA); PG8_STAGE(PG8_SB(1, 1), cB + hstep + kstep, voffB);
        PG8_WAIT_V(6); PG8_BAR;
    }
    for (;;) {
        const bool has_next = S.next(ui + 1, nxt);
        const char* nA = has_next ? (const char*)g.A + (size_t)nxt.pm * tstep : cA; const char* nB = has_next ? (const char*)g.Bt + (size_t)nxt.pn * tstep : cB;
        for (int t = 0; t < nt; t += 2) {
            const bool last = (t == nt - 2);
            const char* a1 = cA + (size_t)(t + 1) * kstep;
            const char* a2 = last ? nA : cA + (size_t)(t + 2) * kstep; const char* b2 = last ? nB : cB + (size_t)(t + 2) * kstep;
            const char* a3 = a2 + kstep; const char* b3 = b2 + kstep;
            if (last && has_next) S.a_ready(nxt);
            if constexpr (SP2) {
            PG8_LDB(B0, 0, 0); PG8_LDB(B1, 0, 1); PG8_SCHED; PG8_LDA(At, 0, 0); PG8_STAGE(PG8_SA(1, 1), a1 + hstep, voffA);
            PG8_WAIT_V(8); PG8_WAIT_L(0); PG8_BAR; PG8_MMA(0, 0, At, B0); PG8_MMA(0, 1, At, B1); PG8_BAR; PG8_SCHED;
            PG8_LDA(At, 0, 1); PG8_STAGE(PG8_SB(0, 0), b2, voffB); PG8_STAGE(PG8_SB(0, 1), b2 + hstep, voffB); PG8_STAGE(PG8_SA(0, 0), a2, voffA);
            PG8_WAIT_V(8); PG8_WAIT_L(0); PG8_BAR; PG8_MMA(1, 0, At, B0); PG8_MMA(1, 1, At, B1); PG8_BAR; PG8_SCHED;
            PG8_LDB(B0, 1, 0); PG8_LDB(B1, 1, 1); PG8_SCHED; PG8_LDA(At, 1, 0); PG8_STAGE(PG8_SA(0, 1), a2 + hstep, voffA);
            PG8_WAIT_V(8); PG8_WAIT_L(0); PG8_BAR; PG8_MMA(0, 0, At, B0); PG8_MMA(0, 1, At, B1); PG8_BAR; PG8_SCHED;
            PG8_LDA(At, 1, 1); PG8_STAGE(PG8_SB(1, 0), b3, voffB); PG8_STAGE(PG8_SB(1, 1), b3 + hstep, voffB); PG8_STAGE(PG8_SA(1, 0), a3, voffA);
            PG8_WAIT_V(8); PG8_WAIT_L(0); PG8_BAR; PG8_MMA(1, 0, At, B0); PG8_MMA(1, 1, At, B1); PG8_BAR; PG8_SCHED;
            } else {
            PG8_LDB(B0, 0, 0); PG8_SCHED; PG8_LDA(At, 0, 0); PG8_STAGE(PG8_SA(1, 1), a1 + hstep, voffA);
            PG8_WAIT_L(8); PG8_BAR; PG8_WAIT_L(0); PG8_MMA(0, 0, At, B0); PG8_BAR; PG8_SCHED;
            PG8_LDB(B1, 0, 1); PG8_STAGE(PG8_SB(0, 0), b2, voffB);
            PG8_BAR; PG8_WAIT_L(0); PG8_MMA(0, 1, At, B1); PG8_BAR;
            PG8_LDA(At, 0, 1); PG8_STAGE(PG8_SA(0, 0), a2, voffA);
            PG8_BAR; PG8_WAIT_L(0); PG8_MMA(1, 0, At, B0); PG8_BAR; PG8_SCHED;
            PG8_STAGE(PG8_SB(0, 1), b2 + hstep, voffB);
            PG8_WAIT_V(6); PG8_BAR; PG8_MMA(1, 1, At, B1); PG8_BAR;
            PG8_LDB(B0, 1, 0); PG8_SCHED; PG8_LDA(At, 1, 0); PG8_STAGE(PG8_SA(0, 1), a2 + hstep, voffA);
            PG8_WAIT_L(8); PG8_BAR; PG8_WAIT_L(0); PG8_MMA(0, 0, At, B0); PG8_BAR; PG8_SCHED;
            PG8_LDB(B1, 1, 1); PG8_STAGE(PG8_SB(1, 0), b3, voffB);
            PG8_BAR; PG8_WAIT_L(0); PG8_MMA(0, 1, At, B1); PG8_BAR;
            PG8_LDA(At, 1, 1); PG8_STAGE(PG8_SA(1, 0), a3, voffA);
            PG8_BAR; PG8_WAIT_L(0); PG8_MMA(1, 0, At, B0); PG8_BAR; PG8_SCHED;
            PG8_STAGE(PG8_SB(1, 1), b3 + hstep, voffB);
            PG8_WAIT_V(6); PG8_BAR; PG8_MMA(1, 1, At, B1); PG8_BAR;
            }
        }
        if constexpr (ALIGN_EPI) { if (wr == 0) PG8_BAR; }
        if constexpr (!Epi::AFTER_DRAIN) { E(acc, cur, wr, wc, fr, fq); S.done(cur); }
        if (!has_next) break;
#pragma unroll
        for (int a = 0; a < 2; ++a)
#pragma unroll
            for (int b = 0; b < 2; ++b)
#pragma unroll
                for (int m = 0; m < 4; ++m)
#pragma unroll
                    for (int n = 0; n < 2; ++n) acc[a][b][m][n] = (f32x4){0.f, 0.f, 0.f, 0.f};
        cur = nxt; cA = nA; cB = nB; ++ui;
        if constexpr (ALIGN_EPI) { if (wr == 1) PG8_BAR; }
    }
    PG8_WAIT_V(0);
    if constexpr (!ALIGN_EPI) { if (wr == 0) PG8_BAR; }
    PG8_BAR;
    if constexpr (Epi::AFTER_DRAIN) { E.fused(acc, cur, wr, wc, fr, fq, lds, wid, lane); S.done(cur); }
#undef PG8_SA
#undef PG8_SB
#undef PG8_STAGE
#undef PG8_LDA
#undef PG8_LDB
#undef PG8_MMA
#undef PG8_WAIT_V
#undef PG8_WAIT_L
#undef PG8_BAR
#undef PG8_SCHED
}
}

#define GAS __attribute__((address_space(1)))
#define LAS __attribute__((address_space(3)))
typedef unsigned short bf16;
typedef unsigned v4u __attribute__((ext_vector_type(4)));
typedef unsigned v2u __attribute__((ext_vector_type(2)));
typedef float f32x4 __attribute__((ext_vector_type(4)));
typedef float f32x16 __attribute__((ext_vector_type(16)));
typedef short bf16x8 __attribute__((ext_vector_type(8)));
typedef unsigned long long u64;

constexpr int BATCH = 16, SEQ = 2048, DM = 1024, DEPTH = 2, M = BATCH * SEQ;
constexpr int IN_COLS = 4168, IN_POS = 4352, FFN = 2816, TOPK = 256;
constexpr float LN_EPS = 1e-5f;
constexpr float DN_ALPHA = 1.4142135623730951f;
constexpr size_t MiB = 1u << 20;
constexpr size_t WS_CTL = 0, CTL_BYTES = 1 * MiB;
constexpr size_t WS_WIN = 1 * MiB, WS_WOUT = 10 * MiB, WS_WGU = 12 * MiB, WS_WDN = 23 * MiB;
constexpr size_t WS_R128 = 29 * MiB, WS_R64 = 45 * MiB;
constexpr size_t WS_B = 53 * MiB;
constexpr size_t WS_C = 117 * MiB;
constexpr size_t WS_D = 245 * MiB;
constexpr size_t D_RQ = 0, D_RK = 32 * MiB, D_RV = 64 * MiB, D_RG = 96 * MiB, D_AQ = 128 * MiB, D_AK = 160 * MiB, D_AV = 192 * MiB, D_IQ = 224 * MiB, D_IK = 256 * MiB, D_IW = 260 * MiB;
constexpr size_t D_H = 0, D_X1B = 176 * MiB;
constexpr size_t WS_END = 506 * MiB;
constexpr size_t O_KV = 0, O_MASK = 64 * MiB;

#ifndef PROBE_DUP
#define PROBE_DUP 0
#endif
struct Args { const void* in[11]; float* out; unsigned char* ws; int layer, ph_lo, ph_hi, pad; };

__device__ __forceinline__ unsigned f2bf(float f) { unsigned u = __builtin_bit_cast(unsigned, f); return (u + 0x7fffu + ((u >> 16) & 1u)) >> 16; }
__device__ __forceinline__ unsigned pk2(float lo, float hi) { return f2bf(lo) | (f2bf(hi) << 16); }
__device__ __forceinline__ float bf2f(unsigned short b) { return __builtin_bit_cast(float, (unsigned)b << 16); }
__device__ __forceinline__ float wave_sum(float v) {
#pragma unroll
    for (int o = 1; o < 64; o <<= 1) v += __shfl_xor(v, o);
    return v;
}

__device__ __forceinline__ int map_in(int p) {
    const int pn = p >> 8, q = p & 255;
    if (pn < 4 || (pn >= 8 && pn < 12)) { const int blk = q >> 7, q7 = q & 127, wc = q7 >> 5, n = (q7 >> 4) & 1, r = q7 & 15; return pn * 256 + blk * 128 + 64 * n + 16 * wc + r; }
    if (pn < 14) { const int g = q >> 5, q5 = q & 31, n = q5 >> 4, fq = (q5 >> 2) & 3, j = q5 & 3; return pn * 256 + g * 32 + 8 * fq + 4 * n + j; }
    if (pn < 16 || q < 64) { const int B = q >> 6, q6 = q & 63, w = q6 >> 5, n = (q6 >> 4) & 1, r = q6 & 15; return pn * 256 + B * 64 + 32 * n + 16 * w + r; }
    if (q < 72) return 4096 + q;
    return -1;
}
__device__ __forceinline__ int map_gu(int p) { const int pn = p >> 8, q = p & 255, bj = q >> 7, q7 = q & 127, wc = q7 >> 5, n = (q7 >> 4) & 1, fq = (q7 >> 2) & 3, j = q7 & 3; return bj * FFN + pn * 128 + 32 * wc + 8 * fq + 4 * n + j; }
template <int MAP> __device__ __forceinline__ void transpose_item(const float* W, int K, int Nsrc, bf16* WT, LAS float* scr, int item, int nblk, int lane) {
    const int kb = item / nblk, nb = item % nblk, k0 = 64 * kb, n0 = 32 * nb;
    const int p = n0 + (lane & 31); const int sc = MAP == 0 ? p : (MAP == 1 ? map_in(p) : map_gu(p));
#pragma unroll 8
    for (int i = 0; i < 32; ++i) { const int kk = 2 * i + (lane >> 5); scr[kk * 33 + (lane & 31)] = sc >= 0 ? W[(size_t)(k0 + kk) * Nsrc + sc] : 0.f; }
    asm volatile("s_waitcnt lgkmcnt(0)" ::: "memory");
    const int c = lane & 7;
#pragma unroll
    for (int j = 0; j < 4; ++j) { const int n = (lane >> 3) + 8 * j; const LAS float* s = scr + (8 * c) * 33 + n;
        v4u o; o.x = pk2(s[0 * 33], s[1 * 33]); o.y = pk2(s[2 * 33], s[3 * 33]); o.z = pk2(s[4 * 33], s[5 * 33]); o.w = pk2(s[6 * 33], s[7 * 33]);
        *(v4u*)(WT + (size_t)(n0 + n) * K + k0 + 8 * c) = o; }
    asm volatile("s_waitcnt lgkmcnt(0)" ::: "memory");
}
__device__ __forceinline__ void convert_weights(const Args& a, int layer, int gw, int ngw, LAS float* scr, int lane) {
    const float* w_in = (const float*)a.in[2] + (size_t)layer * DM * IN_COLS; const float* w_out = (const float*)a.in[4] + (size_t)layer * DM * DM;
    const float* w_gu = (const float*)a.in[7] + (size_t)layer * DM * 2 * FFN; const float* w_dn = (const float*)a.in[8] + (size_t)layer * FFN * DM;
    bf16* WIN = (bf16*)(a.ws + WS_WIN); bf16* WOUT = (bf16*)(a.ws + WS_WOUT); bf16* WGU = (bf16*)(a.ws + WS_WGU); bf16* WDN = (bf16*)(a.ws + WS_WDN);
    constexpr int I_IN = (DM / 64) * (IN_POS / 32), I_OUT = (DM / 64) * (DM / 32), I_GU = (DM / 64) * (2 * FFN / 32), I_DN = (FFN / 64) * (DM / 32);
    for (int it = gw; it < I_IN + I_OUT + I_GU + I_DN; it += ngw) {
        int r = it;
        if (r < I_IN) { transpose_item<1>(w_in, DM, IN_COLS, WIN, scr, r, IN_POS / 32, lane); continue; } r -= I_IN;
        if (r < I_OUT) { transpose_item<0>(w_out, DM, DM, WOUT, scr, r, DM / 32, lane); continue; } r -= I_OUT;
        if (r < I_GU) { transpose_item<2>(w_gu, DM, 2 * FFN, WGU, scr, r, 2 * FFN / 32, lane); continue; } r -= I_GU;
        transpose_item<0>(w_dn, FFN, DM, WDN, scr, r, DM / 32, lane);
    }
}
__device__ __forceinline__ void convert_x_and_rope(const Args& a, int gt, int ngt) {
    const float* x = (const float*)a.in[0]; bf16* xb = (bf16*)(a.ws + WS_B);
    for (size_t i = gt; i < (size_t)M * DM / 8; i += ngt) { const f32x4 v0 = *(const f32x4*)(x + i * 8), v1 = *(const f32x4*)(x + i * 8 + 4);
        v4u o; o.x = pk2(v0[0], v0[1]); o.y = pk2(v0[2], v0[3]); o.z = pk2(v1[0], v1[1]); o.w = pk2(v1[2], v1[3]); *(v4u*)(xb + i * 8) = o; }
    const int* pos = (const int*)a.in[1]; float* r128 = (float*)(a.ws + WS_R128); float* r64 = (float*)(a.ws + WS_R64);
    for (int i = gt; i < M * 64; i += ngt) { const int row = i >> 6, f = i & 63;
        const float inv = (float)exp2(-(double)f * (13.287712379549449 / 64.0));
        const float ang = (float)pos[row] * inv;
        double rev = (double)ang * 0.15915494309189535; rev -= floor(rev); if (rev > 0.5) rev -= 1.0;
        const float r = (float)(rev * 6.283185307179586);
        const float c = cosf(r), s = sinf(r);
        r128[(size_t)i * 2] = c; r128[(size_t)i * 2 + 1] = s;
        if ((f & 1) == 0) { r64[((size_t)row * 32 + (f >> 1)) * 2] = c; r64[((size_t)row * 32 + (f >> 1)) * 2 + 1] = s; } }
}
__device__ __forceinline__ void ln_rows(const float* in, const float* g, const float* bta, float* outf, bf16* outb, int gw, int ngw, int lane) {
    f32x4 gv[4], bv[4];
#pragma unroll
    for (int j = 0; j < 4; ++j) { gv[j] = *(const f32x4*)(g + 4 * lane + 256 * j); bv[j] = *(const f32x4*)(bta + 4 * lane + 256 * j); }
    for (int m = gw; m < M; m += ngw) {
        const f32x4* xr = (const f32x4*)(in + (size_t)m * DM) + lane; f32x4 v[4]; float s = 0.f;
#pragma unroll
        for (int j = 0; j < 4; ++j) { v[j] = xr[64 * j]; s += (v[j][0] + v[j][1]) + (v[j][2] + v[j][3]); }
        const float mean = wave_sum(s) * (1.f / DM); float s2 = 0.f;
#pragma unroll
        for (int j = 0; j < 4; ++j) { v[j] = v[j] - mean; s2 += (v[j][0] * v[j][0] + v[j][1] * v[j][1]) + (v[j][2] * v[j][2] + v[j][3] * v[j][3]); }
        const float rstd = 1.f / sqrtf(wave_sum(s2) * (1.f / DM) + LN_EPS);
#pragma unroll
        for (int j = 0; j < 4; ++j) { const f32x4 y = v[j] * rstd * gv[j] + bv[j];
            *((f32x4*)(outf + (size_t)m * DM) + lane + 64 * j) = y;
            if (outb) { v2u o; o.x = pk2(y[0], y[1]); o.y = pk2(y[2], y[3]); *((v2u*)(outb + (size_t)m * DM) + lane + 64 * j) = o; } }
    }
}

__device__ __forceinline__ unsigned okey(float f) { const unsigned u = __builtin_bit_cast(unsigned, f); return (u & 0x80000000u) ? ~u : (u | 0x80000000u); }

constexpr int TS = 272;
constexpr int TILE_B = 128 * TS;
__device__ __forceinline__ int crow(int r, int hi) { return (r & 3) + 8 * (r >> 2) + 4 * hi; }
__device__ __forceinline__ void mm128(f32x16 (&acc)[2], const LAS unsigned char* A, const LAS unsigned char* Bt, int wr, int wc, int r32, int hi) {
    const LAS unsigned char* ap = A + (32 * wr + r32) * TS + hi * 16; const LAS unsigned char* bp = Bt + (64 * wc + r32) * TS + hi * 16;
#pragma unroll
    for (int s = 0; s < 8; ++s) {
        const bf16x8 av = *(const LAS bf16x8*)(ap + s * 32), b0 = *(const LAS bf16x8*)(bp + s * 32), b1 = *(const LAS bf16x8*)(bp + 32 * TS + s * 32);
        acc[0] = __builtin_amdgcn_mfma_f32_32x32x16_bf16(av, b0, acc[0], 0, 0, 0); acc[1] = __builtin_amdgcn_mfma_f32_32x32x16_bf16(av, b1, acc[1], 0, 0, 0);
    }
}
__device__ __forceinline__ void tile_load_nat(LAS unsigned char* T, const bf16* g, int ld, int tid) {
#pragma unroll
    for (int i = 0; i < 4; ++i) { const int row = (tid >> 4) + 32 * i, ch = tid & 15; *(LAS v4u*)(T + row * TS + ch * 16) = *(const v4u*)(g + (size_t)row * ld + ch * 8); }
}
template <bool SC> __device__ __forceinline__ void tile_load_tr(LAS unsigned char* T, const bf16* g, int ld, int tid, float sc) {
    const int j = tid & 127;
#pragma unroll
    for (int i = 0; i < 4; ++i) { const int c8 = (tid >> 7) + 4 * i; const v4u v = *(const v4u*)(g + (size_t)j * ld + c8 * 8);
#pragma unroll
        for (int q = 0; q < 8; ++q) { unsigned x = (v[q >> 1] >> ((q & 1) * 16)) & 0xffffu; if (SC) x = f2bf(bf2f((unsigned short)x) * sc);
            *(LAS unsigned short*)(T + (c8 * 8 + q) * TS + j * 2) = (unsigned short)x; } }
}
constexpr size_t O_ST = 72 * MiB;
__device__ __forceinline__ unsigned cvtpk_c(float lo, float hi) { typedef float f2 __attribute__((ext_vector_type(2))); typedef __bf16 b2 __attribute__((ext_vector_type(2))); f2 v = {lo, hi}; b2 r = __builtin_convertvector(v, b2); return __builtin_bit_cast(unsigned, r); }
typedef short s16x4 __attribute__((ext_vector_type(4)));
__device__ __forceinline__ bf16x8 tr_pair(const LAS unsigned char* p, int off2) {
    const s16x4 lo = __builtin_bit_cast(s16x4, __builtin_amdgcn_ds_read_tr16_b64_v4i16((LAS s16x4*)p)), hi = __builtin_bit_cast(s16x4, __builtin_amdgcn_ds_read_tr16_b64_v4i16((LAS s16x4*)(p + off2)));
    return (bf16x8){lo[0], lo[1], lo[2], lo[3], hi[0], hi[1], hi[2], hi[3]};
}
constexpr int VS = 80;
__device__ __forceinline__ void ret_state_phase(LAS unsigned char* lds, const Args& a, int blk, int nblk) {
    const int tid = opaque_tid(), lane = tid & 63, wid = __builtin_amdgcn_readfirstlane(tid >> 6), c = lane & 15, g = lane >> 4, q = (lane >> 2) & 3, p = lane & 3;
    LAS unsigned char* Tk = lds; LAS unsigned char* Tv = lds + TILE_B;
    unsigned char* wsp = opq(a.ws); const GAS bf16* rk = (const GAS bf16*)(wsp + WS_D + D_RK); const GAS bf16* rv = (const GAS bf16*)(wsp + WS_D + D_RV);
    GAS bf16* St = (GAS bf16*)((unsigned char*)opq(a.out) + O_ST);
    for (int it = blk; it < 256; it += nblk) {
        const int eb = it & 3, h = (it >> 2) & 3, b = it >> 4;
        const float l2g = log2f(1.0f - exp2f(-5.0f - (float)h)), gC = exp2f(128.f * l2g);
        float dec[4];
#pragma unroll
        for (int i = 0; i < 4; ++i) dec[i] = exp2f((float)(127 - ((tid >> 4) + 32 * i)) * l2g);
        const GAS bf16* kbase = rk + ((size_t)b * SEQ) * 512 + h * 128 + (tid & 15) * 8; const GAS bf16* vbase = rv + ((size_t)b * SEQ + (tid >> 2)) * 512 + h * 128 + eb * 32 + (tid & 3) * 8;
        v4u kr[4], vr;
#define RS_LOAD(n_) do { _Pragma("unroll") for (int i = 0; i < 4; ++i) kr[i] = *(const GAS v4u*)(kbase + (size_t)((n_) * 128 + (tid >> 4) + 32 * i) * 512); vr = *(const GAS v4u*)(vbase + (size_t)(n_) * 128 * 512); } while (0)
        RS_LOAD(0);
        f32x4 st0 = (f32x4){0.f, 0.f, 0.f, 0.f}, st1 = st0;
        const LAS unsigned char* ap = Tk + (8 * g + q) * TS + (16 * wid + 4 * p) * 2; const LAS unsigned char* bp = Tv + (8 * g + q) * VS + (4 * p) * 2;
        for (int n = 0; n < 15; ++n) {
            __syncthreads();
#pragma unroll
            for (int i = 0; i < 4; ++i) { v4u o;
#pragma unroll
                for (int w2 = 0; w2 < 4; ++w2) { const unsigned x = kr[i][w2]; o[w2] = cvtpk_c(__uint_as_float(x << 16) * dec[i], __uint_as_float(x & 0xffff0000u) * dec[i]); }
                *(LAS v4u*)(Tk + ((tid >> 4) + 32 * i) * TS + (tid & 15) * 16) = o; }
            *(LAS v4u*)(Tv + (tid >> 2) * VS + (tid & 3) * 16) = vr;
            if (n + 1 < 15) RS_LOAD(n + 1);
            __syncthreads();
            f32x4 a0 = (f32x4){0.f, 0.f, 0.f, 0.f}, a1 = a0;
#pragma unroll
            for (int ks = 0; ks < 4; ++ks) { const bf16x8 af = tr_pair(ap + ks * 32 * TS, 4 * TS), b0 = tr_pair(bp + ks * 32 * VS, 4 * VS), b1 = tr_pair(bp + ks * 32 * VS + 32, 4 * VS);
                a0 = __builtin_amdgcn_mfma_f32_16x16x32_bf16(af, b0, a0, 0, 0, 0); a1 = __builtin_amdgcn_mfma_f32_16x16x32_bf16(af, b1, a1, 0, 0, 0); }
            st0 = st0 * gC + a0; st1 = st1 * gC + a1;
            GAS bf16* so = St + ((size_t)(b * 4 + h) * 15 + n) * 16384 + (size_t)(eb * 32 + c) * 128 + 16 * wid + 4 * g;
            v2u o0, o1; o0.x = cvtpk_c(st0[0], st0[1]); o0.y = cvtpk_c(st0[2], st0[3]); o1.x = cvtpk_c(st1[0], st1[1]); o1.y = cvtpk_c(st1[2], st1[3]);
            *(GAS v2u*)so = o0; *(GAS v2u*)(so + 16 * 128) = o1;
        }
#undef RS_LOAD
        __syncthreads();
    }
}
__device__ __forceinline__ void ret_out_phase(LAS unsigned char* lds, const Args& a, int layer, int blk, int nblk) {
    const int tid = opaque_tid(), lane = tid & 63, wid = __builtin_amdgcn_readfirstlane(tid >> 6), r32 = lane & 31, hi = lane >> 5, ib = wid & 3, eh = wid >> 2;
    const int gq = lane >> 4, q = (lane >> 2) & 3, p = lane & 3;
    LAS unsigned char* Tk = lds; LAS unsigned char* Tv = lds + TILE_B; LAS unsigned char* Tst = lds + 2 * TILE_B; LAS float* Ex = (LAS float*)(lds + 3 * TILE_B);
    LAS float* Of = (LAS float*)lds;
    unsigned char* wsp = opq(a.ws); unsigned char* D = wsp + WS_D; const GAS bf16* rq = (const GAS bf16*)(D + D_RQ); const GAS bf16* rk = (const GAS bf16*)(D + D_RK); const GAS bf16* rv = (const GAS bf16*)(D + D_RV); const GAS bf16* rg = (const GAS bf16*)(D + D_RG);
    const GAS bf16* St = (const GAS bf16*)((const unsigned char*)opq(a.out) + O_ST); GAS bf16* mix = (GAS bf16*)(wsp + WS_B); const GAS float* gain = (const GAS float*)a.in[3] + layer * 512;
    for (int it = blk; it < 1024; it += nblk) {
        const int n = it & 15, h = (it >> 4) & 3, b = it >> 6;
        const float l2g = log2f(1.0f - exp2f(-5.0f - (float)h));
        const size_t row0 = (size_t)b * SEQ + n * 128;
        bf16x8 qf[8];
#pragma unroll
        for (int s = 0; s < 8; ++s) qf[s] = *(const GAS bf16x8*)(rq + (row0 + 32 * ib + r32) * 512 + h * 128 + 16 * s + 8 * hi);
#pragma unroll
        for (int i = 0; i < 4; ++i) { const int row = (tid >> 4) + 32 * i, ch = tid & 15;
            *(LAS v4u*)(Tk + row * TS + ch * 16) = *(const GAS v4u*)(rk + (row0 + row) * 512 + h * 128 + ch * 8);
            *(LAS v4u*)(Tv + row * TS + ch * 16) = *(const GAS v4u*)(rv + (row0 + row) * 512 + h * 128 + ch * 8);
            if (n > 0) *(LAS v4u*)(Tst + row * TS + ch * 16) = *(const GAS v4u*)(St + ((size_t)(b * 4 + h) * 15 + (n - 1)) * 16384 + row * 128 + ch * 8); }
        __syncthreads();
        f32x16 oT[2]; oT[0] = f32x16{}; oT[1] = f32x16{};
        if (n > 0) {
#pragma unroll
            for (int eb = 0; eb < 2; ++eb) { const LAS unsigned char* sp = Tst + (64 * eh + 32 * eb + r32) * TS + hi * 16;
#pragma unroll
                for (int s = 0; s < 8; ++s) oT[eb] = __builtin_amdgcn_mfma_f32_32x32x16_bf16(*(const LAS bf16x8*)(sp + s * 32), qf[s], oT[eb], 0, 0, 0); }
            const float dq = __builtin_amdgcn_exp2f((float)(32 * ib + r32 + 1) * l2g);
            oT[0] = oT[0] * dq; oT[1] = oT[1] * dq;
        }
        for (int jb = 0; jb <= ib; ++jb) {
            f32x16 X = f32x16{}; const LAS unsigned char* kp = Tk + (32 * jb + r32) * TS + hi * 16;
#pragma unroll
            for (int s = 0; s < 8; ++s) X = __builtin_amdgcn_mfma_f32_32x32x16_bf16(*(const LAS bf16x8*)(kp + s * 32), qf[s], X, 0, 0, 0);
            const int dij = 32 * (ib - jb) + r32 - 4 * hi;
#pragma unroll
            for (int r = 0; r < 16; ++r) { const int d = dij - ((r & 3) + 8 * (r >> 2)); X[r] = d >= 0 ? X[r] * __builtin_amdgcn_exp2f((float)d * l2g) : 0.f; }
            v4u x0, x1; x0.x = cvtpk_c(X[0], X[1]); x0.y = cvtpk_c(X[2], X[3]); x0.z = cvtpk_c(X[4], X[5]); x0.w = cvtpk_c(X[6], X[7]);
            x1.x = cvtpk_c(X[8], X[9]); x1.y = cvtpk_c(X[10], X[11]); x1.z = cvtpk_c(X[12], X[13]); x1.w = cvtpk_c(X[14], X[15]);
            const bf16x8 xs0 = __builtin_bit_cast(bf16x8, x0), xs1 = __builtin_bit_cast(bf16x8, x1);
            const LAS unsigned char* vp = Tv + (32 * jb + 4 * (gq >> 1) + q) * TS + (64 * eh + 16 * (gq & 1) + 4 * p) * 2;
#pragma unroll
            for (int eb = 0; eb < 2; ++eb) {
                oT[eb] = __builtin_amdgcn_mfma_f32_32x32x16_bf16(tr_pair(vp + eb * 64, 8 * TS), xs0, oT[eb], 0, 0, 0);
                oT[eb] = __builtin_amdgcn_mfma_f32_32x32x16_bf16(tr_pair(vp + eb * 64 + 16 * TS, 8 * TS), xs1, oT[eb], 0, 0, 0); }
        }
        float s1 = 0.f;
#pragma unroll
        for (int r = 0; r < 16; ++r) s1 += oT[0][r] + oT[1][r];
        { auto rr = __builtin_amdgcn_permlane32_swap(__float_as_uint(s1), __float_as_uint(s1), false, false); s1 = __uint_as_float(rr[0]) + __uint_as_float(rr[1]); }
        if (hi == 0) Ex[eh * 128 + 32 * ib + r32] = s1;
        __syncthreads();
        const float mean = (Ex[32 * ib + r32] + Ex[128 + 32 * ib + r32]) * (1.f / 128.f);
        float s2 = 0.f;
#pragma unroll
        for (int r = 0; r < 16; ++r) { oT[0][r] -= mean; oT[1][r] -= mean; s2 += oT[0][r] * oT[0][r] + oT[1][r] * oT[1][r]; }
        { auto rr = __builtin_amdgcn_permlane32_swap(__float_as_uint(s2), __float_as_uint(s2), false, false); s2 = __uint_as_float(rr[0]) + __uint_as_float(rr[1]); }
        if (hi == 0) Ex[256 + eh * 128 + 32 * ib + r32] = s2;
        __syncthreads();
        const float rstd = 1.0f / sqrtf((Ex[256 + 32 * ib + r32] + Ex[384 + 32 * ib + r32]) * (1.f / 128.f) + LN_EPS);
#pragma unroll
        for (int eb = 0; eb < 2; ++eb)
#pragma unroll
            for (int u = 0; u < 4; ++u) { const int e0 = 64 * eh + 32 * eb + 8 * u + 4 * hi; const f32x4 gv = *(const GAS f32x4*)(gain + h * 128 + e0);
                f32x4 y; y[0] = oT[eb][4 * u] * rstd * gv[0]; y[1] = oT[eb][4 * u + 1] * rstd * gv[1]; y[2] = oT[eb][4 * u + 2] * rstd * gv[2]; y[3] = oT[eb][4 * u + 3] * rstd * gv[3];
                *(LAS f32x4*)(Of + (32 * ib + r32) * 132 + e0) = y; }
        __syncthreads();
        {
            const int row = tid >> 2, pt = tid & 3; const GAS bf16* gp = rg + (row0 + row) * 512 + h * 128 + 32 * pt; GAS bf16* mp = mix + (row0 + row) * 1024 + h * 128 + 32 * pt;
#pragma unroll
            for (int k = 0; k < 4; ++k) { const v4u gg = *(const GAS v4u*)(gp + 8 * k); const f32x4 y0 = *(const LAS f32x4*)(Of + row * 132 + 32 * pt + 8 * k), y1 = *(const LAS f32x4*)(Of + row * 132 + 32 * pt + 8 * k + 4);
                v4u o; o.x = cvtpk_c(y0[0] * __uint_as_float(gg.x << 16), y0[1] * __uint_as_float(gg.x & 0xffff0000u)); o.y = cvtpk_c(y0[2] * __uint_as_float(gg.y << 16), y0[3] * __uint_as_float(gg.y & 0xffff0000u));
                o.z = cvtpk_c(y1[0] * __uint_as_float(gg.z << 16), y1[1] * __uint_as_float(gg.z & 0xffff0000u)); o.w = cvtpk_c(y1[2] * __uint_as_float(gg.w << 16), y1[3] * __uint_as_float(gg.w & 0xffff0000u));
                *(GAS v4u*)(mp + 8 * k) = o; }
        }
        __syncthreads();
    }
}
constexpr int SROW = 2052;
__device__ __forceinline__ float unkey(unsigned k) { const unsigned u = (k & 0x80000000u) ? (k & 0x7fffffffu) : ~k; return __builtin_bit_cast(float, u); }
__device__ __forceinline__ unsigned wave_max_u32(unsigned v) {
#pragma unroll
    for (int o = 1; o < 64; o <<= 1) { const unsigned x = (unsigned)__shfl_xor((int)v, o); v = x > v ? x : v; }
    return v;
}
__device__ __forceinline__ void idx_group(LAS float* Sc, int gi, const bf16x8 (&kf)[4][2], const bf16x8 (&qf)[8][2], const float (&wv)[8], int c, int g) {
#pragma unroll
    for (int tt = 0; tt < 4; ++tt) {
        float s4[4] = {0.f, 0.f, 0.f, 0.f};
#pragma unroll
        for (int h = 0; h < 8; ++h) { f32x4 ac = __builtin_amdgcn_mfma_f32_16x16x32_bf16(kf[tt][0], qf[h][0], (f32x4){0.f, 0.f, 0.f, 0.f}, 0, 0, 0);
            ac = __builtin_amdgcn_mfma_f32_16x16x32_bf16(kf[tt][1], qf[h][1], ac, 0, 0, 0);
#pragma unroll
            for (int r = 0; r < 4; ++r) { const float av = ac[r]; const int xi = __float_as_int(av); const float rl = __int_as_float(xi > 0 ? xi : 0);
                asm("v_fmac_f32 %0, %1, %2" : "+v"(s4[r]) : "v"(wv[h]), "v"(rl)); } }
        *(LAS f32x4*)(Sc + c * SROW + gi * 64 + tt * 16 + 4 * g) = (f32x4){s4[0] + 0.0f, s4[1] + 0.0f, s4[2] + 0.0f, s4[3] + 0.0f};
    }
}
template <int SEL> __device__ __forceinline__ int wlane(int val, int old) { asm volatile("s_nop 3\n\tv_writelane_b32 %0, %1, %2" : "+v"(old) : "s"(val), "n"(SEL)); return old; }
__device__ __forceinline__ int wave_sum_i32(int v) {
    v += __builtin_amdgcn_update_dpp(0, v, 0x111, 0xf, 0xf, true);
    v += __builtin_amdgcn_update_dpp(0, v, 0x112, 0xf, 0xf, true);
    v += __builtin_amdgcn_update_dpp(0, v, 0x114, 0xf, 0xf, true);
    v += __builtin_amdgcn_update_dpp(0, v, 0x118, 0xf, 0xf, true);
    return __builtin_amdgcn_readlane(v, 15) + __builtin_amdgcn_readlane(v, 31) + __builtin_amdgcn_readlane(v, 47) + __builtin_amdgcn_readlane(v, 63);
}
__device__ __forceinline__ int count_ge(const unsigned (&key)[32], unsigned cand, int imax) {
    int c0 = 0, c1 = 0;
#pragma unroll
    for (int gq = 0; gq < 4; ++gq) if (imax > 8 * gq) {
#pragma unroll
        for (int i = 0; i < 8; i += 2) { c0 += (key[8 * gq + i] >= cand) ? 1 : 0; c1 += (key[8 * gq + i + 1] >= cand) ? 1 : 0; }
#pragma unroll
        for (int i = 0; i < 8; i += 2) { } }
    return wave_sum_i32(c0 + c1);
}
__device__ __forceinline__ void idx_phase(LAS unsigned char* lds, const Args& a, int blk, int nblk) {
    const int tid = opaque_tid(), lane = tid & 63, wid = __builtin_amdgcn_readfirstlane(tid >> 6), c = lane & 15, g = lane >> 4;
    LAS float* Sc = (LAS float*)lds;
    unsigned char* D = opq(a.ws) + WS_D; const GAS bf16* iq = (const GAS bf16*)(D + D_IQ); const GAS bf16* ik = (const GAS bf16*)(D + D_IK); const GAS float* iw = (const GAS float*)(D + D_IW);
    GAS u64* mask = (GAS u64*)((unsigned char*)opq(a.out) + O_MASK);
#define IDX_LOADK(dst, gi_) do { const GAS bf16* kp_ = ik + ((size_t)b * SEQ + (gi_) * 64 + c) * 64 + g * 8; \
        _Pragma("unroll") for (int tt_ = 0; tt_ < 4; ++tt_) { dst[tt_][0] = *(const GAS bf16x8*)(kp_ + tt_ * 1024); dst[tt_][1] = *(const GAS bf16x8*)(kp_ + tt_ * 1024 + 32); } } while (0)
    for (int it = blk; it < BATCH * 64; it += nblk) {
        const int b = (it >> 2) & 15, qb = 16 * (it >> 8) + 4 * ((it >> 6) & 3) + (it & 3);
        for (int half = 0; half < 2; ++half) {
            const int q0 = qb * 32 + half * 16, ngroup = q0 / 64 + 1;
            for (int rep_s = 0; rep_s < ((PROBE_DUP == 12) ? 2 : 1); ++rep_s) {
                const size_t rowq = (size_t)b * SEQ + q0 + c;
                bf16x8 qf[8][2];
#pragma unroll
                for (int h = 0; h < 8; ++h) { qf[h][0] = *(const GAS bf16x8*)(iq + rowq * 512 + h * 64 + g * 8); qf[h][1] = *(const GAS bf16x8*)(iq + rowq * 512 + h * 64 + 32 + g * 8); }
                const f32x4 w0 = *(const GAS f32x4*)(iw + rowq * 8), w1 = *(const GAS f32x4*)(iw + rowq * 8 + 4);
                const float wv[8] = {w0[0], w0[1], w0[2], w0[3], w1[0], w1[1], w1[2], w1[3]};
                bf16x8 kA[4][2], kB[4][2];
                int gi = wid;
                if (gi < ngroup) IDX_LOADK(kA, gi);
                for (; gi < ngroup; gi += 16) {
                    if (gi + 8 < ngroup) IDX_LOADK(kB, gi + 8);
                    idx_group(Sc, gi, kA, qf, wv, c, g);
                    if (gi + 16 < ngroup) IDX_LOADK(kA, gi + 16);
                    if (gi + 8 < ngroup) idx_group(Sc, gi + 8, kB, qf, wv, c, g);
                }
            }
            __syncthreads();
            for (int rep_u = 0; rep_u < ((PROBE_DUP == 13) ? 2 : 1); ++rep_u)
            for (int u = 0; u < 2; ++u) {
                const int cq = 2 * wid + u, t = q0 + cq, imax = t / 64 + 1;
                int mlo = 0, mhi = 0;
                if (t < TOPK) {
#define IDX_W0(i) do { const u64 w = __ballot(64 * (i) + lane <= t); mlo = wlane<(i)>((int)(unsigned)w, mlo); mhi = wlane<(i)>((int)(unsigned)(w >> 32), mhi); } while (0)
                    IDX_W0(0); IDX_W0(1); IDX_W0(2); IDX_W0(3);
#undef IDX_W0
                } else {
                    unsigned key[32]; unsigned kmx = 0u, kmn = 0xffffffffu;
                    for (int rep_k = 0; rep_k < ((PROBE_DUP == 14) ? 2 : 1); ++rep_k) {
#pragma unroll
                    for (int gq = 0; gq < 4; ++gq) {
#pragma unroll
                        for (int i = 8 * gq; i < 8 * gq + 8; ++i) key[i] = 0u;
                        if (imax > 8 * gq) {
                            float sv[8];
#pragma unroll
                            for (int i = 0; i < 8; ++i) sv[i] = Sc[cq * SROW + 64 * (8 * gq + i) + lane];
#pragma unroll
                            for (int i = 0; i < 8; ++i) { const unsigned k = (64 * (8 * gq + i) + lane <= t) ? okey(sv[i]) : 0u; key[8 * gq + i] = k; kmx = k > kmx ? k : kmx; const unsigned kk = k ? k : 0xffffffffu; kmn = kk < kmn ? kk : kmn; } } }
                    }
                    for (int rep_r = 0; rep_r < ((PROBE_DUP == 18) ? 2 : 1); ++rep_r) { kmx = wave_max_u32(kmx); kmn = ~wave_max_u32(~kmn); }
                    unsigned lo, hi, thr; int clo, chi, need;
                    for (int rep_b = 0; rep_b < ((PROBE_DUP == 15) ? 2 : 1); ++rep_b) { lo = (unsigned)__builtin_amdgcn_readfirstlane((int)kmn); hi = (unsigned)__builtin_amdgcn_readfirstlane((int)kmx) + 1u; clo = t + 1; chi = 0; asm volatile("" : "+s"(lo), "+s"(hi));
                    for (int step = 0;; ++step) {
                        if (hi - lo <= 1u) { thr = lo; need = TOPK - chi; break; }
                        const float lv = unkey(lo), hv = unkey(hi);
                        const float fr = (step & 1) ? 0.5f : ((float)(clo - TOPK) + 0.5f) / (float)(clo - chi);
                        unsigned mid = okey(lv + (hv - lv) * fr); mid = mid <= lo ? lo + 1u : (mid >= hi ? hi - 1u : mid);
                        int cnt = count_ge(key, mid, imax);
                        if (PROBE_DUP == 20) { unsigned m2 = (unsigned)__builtin_amdgcn_readfirstlane((int)(mid ^ 0u)); asm volatile("" : "+s"(m2)); const int c2 = count_ge(key, m2, imax); cnt = c2 < cnt ? c2 : cnt; }
                        if (cnt == TOPK) { thr = mid - 1u; need = 0; break; }
                        if (cnt > TOPK) { lo = mid; clo = cnt; } else { hi = mid; chi = cnt; }
                    }
                    }
                    if (PROBE_DUP == 19) { int dummy = 0;
#pragma unroll 1
                        for (int k = 0; k < 8; ++k) { unsigned cd = (unsigned)__builtin_amdgcn_readfirstlane((int)(thr + (unsigned)k)); dummy += count_ge(key, cd, imax); }
                        asm volatile("" :: "v"(dummy)); }
                    for (int rep_m = 0; rep_m < ((PROBE_DUP == 16) ? 2 : 1); ++rep_m) {
                    if (need == 0) {
#define IDX_W1(i) do { const u64 w = __ballot(key[i] > thr); mlo = wlane<(i)>((int)(unsigned)w, mlo); mhi = wlane<(i)>((int)(unsigned)(w >> 32), mhi); } while (0)
#define IDX_W8(b_) do { IDX_W1((b_) + 0); IDX_W1((b_) + 1); IDX_W1((b_) + 2); IDX_W1((b_) + 3); IDX_W1((b_) + 4); IDX_W1((b_) + 5); IDX_W1((b_) + 6); IDX_W1((b_) + 7); } while (0)
                        IDX_W8(0); if (imax > 8) IDX_W8(8); if (imax > 16) IDX_W8(16); if (imax > 24) IDX_W8(24);
#undef IDX_W8
#undef IDX_W1
                    } else {
                    int eqc = 0;
#define IDX_W1(i) do { const u64 em = __ballot(key[i] == thr); \
                            const int rank = eqc + (int)__builtin_amdgcn_mbcnt_hi((unsigned)(em >> 32), __builtin_amdgcn_mbcnt_lo((unsigned)em, 0u)); \
                            const int selv = (int)(key[i] > thr) | ((int)(key[i] == thr) & (int)(rank < need)); \
                            const u64 w = __ballot(selv != 0); eqc += __popcll(em); mlo = wlane<(i)>((int)(unsigned)w, mlo); mhi = wlane<(i)>((int)(unsigned)(w >> 32), mhi); } while (0)
#define IDX_W8(b_) do { IDX_W1((b_) + 0); IDX_W1((b_) + 1); IDX_W1((b_) + 2); IDX_W1((b_) + 3); IDX_W1((b_) + 4); IDX_W1((b_) + 5); IDX_W1((b_) + 6); IDX_W1((b_) + 7); } while (0)
                    IDX_W8(0); if (imax > 8) IDX_W8(8); if (imax > 16) IDX_W8(16); if (imax > 24) IDX_W8(24);
                    }
#undef IDX_W8
#undef IDX_W1
                    }
                }
                for (int rep_w = 0; rep_w < ((PROBE_DUP == 17) ? 2 : 1); ++rep_w) { if (lane < 32) mask[((size_t)b * 32 + lane) * SEQ + t] = ((u64)(unsigned)mhi << 32) | (u64)(unsigned)mlo; asm volatile("" ::: "memory"); }
            }
            __syncthreads();
        }
    }
#undef IDX_LOADK
}

namespace att {
constexpr int D = 128, NW = 8, QBLK = 32, KVBLK = 64, QB = NW * QBLK, LDO = 1024;
constexpr int SHM_V = KVBLK * D * 2, SHM_K = KVBLK * D * 2;
constexpr int LDS_BYTES = 2 * SHM_V + 2 * SHM_K + NW * 64 * 4;
constexpr float SCALE = 0.08838834764831845f, THR = 8.f;
typedef short s16x4 __attribute__((ext_vector_type(4)));
#define KSWZ(row, colB) ((row) * 256 + ((colB) ^ (((row) & 7) << 4)))
#define SBAR() __builtin_amdgcn_sched_barrier(0)
__device__ __forceinline__ int v_st(int k, int c) { const int kk = (k & ~0xC) | ((k & 4) << 1) | ((k & 8) >> 1); return ((kk >> 3) * 4 + (c >> 5)) * 512 + ((kk & 7) * 32 + (c & 31)) * 2; }
__device__ __forceinline__ int v_rd_base(int lane) { return ((lane & 3) << 3) | (((lane >> 2) & 3) << 6) | (((lane >> 4) & 1) << 5) | (((lane >> 5) & 1) << 8); }
constexpr int v_rd_off(int d0, int ks, int half) { return d0 * 512 + ks * 4096 + half * 2048; }
__device__ __forceinline__ unsigned cvtpk(float lo, float hi) { unsigned r; asm volatile("v_cvt_pk_bf16_f32 %0, %1, %2" : "=v"(r) : "v"(lo), "v"(hi)); return r; }
__device__ __forceinline__ bf16x8 load8(const bf16* p) { return *reinterpret_cast<const bf16x8*>(p); }
__device__ __forceinline__ void mask_bits(f32x16& p0, f32x16& p1, u64 mw, int hi) {
    const float NEG = -__builtin_inff();
    const unsigned lo = (unsigned)mw >> (4 * hi), h2 = (unsigned)(mw >> 32) >> (4 * hi);
#pragma unroll
    for (int r = 0; r < 16; ++r) { const int c = (r & 3) + 8 * (r >> 2);
        if (!((lo >> c) & 1u)) p0[r] = NEG;
        if (!((h2 >> c) & 1u)) p1[r] = NEG; }
}
__device__ __forceinline__ void partialSM(f32x16& p0, f32x16& p1, float& m_reg, float& mn, float& alpha) {
    float pmax = p0[0]; for (int r = 1; r < 16; ++r) pmax = fmaxf(pmax, p0[r]); for (int r = 0; r < 16; ++r) pmax = fmaxf(pmax, p1[r]);
    { auto rr = __builtin_amdgcn_permlane32_swap(__float_as_uint(pmax), __float_as_uint(pmax), false, false);
      pmax = fmaxf(__uint_as_float(rr[0]), __uint_as_float(rr[1])); }
    constexpr float C2 = 1.4426950408889634f * SCALE;
    if (__builtin_expect(__all((pmax - m_reg) * SCALE <= THR), 1)) { mn = m_reg; alpha = 1.f; }
    else { mn = fmaxf(m_reg, pmax); alpha = __builtin_amdgcn_exp2f((m_reg - mn) * C2); m_reg = mn; }
    const float mnL = -mn * C2;
    for (int r = 0; r < 16; ++r) p0[r] = fmaf(p0[r], C2, mnL); for (int r = 0; r < 16; ++r) p1[r] = fmaf(p1[r], C2, mnL);
    for (int r = 0; r < 16; ++r) p0[r] = __builtin_amdgcn_exp2f(p0[r]);
}
__device__ __forceinline__ void finishSM(f32x16& p0, f32x16& p1, float alpha, float& l_reg, bf16x8& pa0, bf16x8& pa1, bf16x8& pa2, bf16x8& pa3) {
    for (int r = 0; r < 16; ++r) p1[r] = __builtin_amdgcn_exp2f(p1[r]);
    float ps = 0; for (int r = 0; r < 16; ++r) ps += p0[r]; for (int r = 0; r < 16; ++r) ps += p1[r];
    { auto rr = __builtin_amdgcn_permlane32_swap(__float_as_uint(ps), __float_as_uint(ps), false, false);
      ps = __uint_as_float(rr[0]) + __uint_as_float(rr[1]); }
    l_reg = l_reg * alpha + ps;
#define PK4(P, B_, OUT) do { unsigned a0 = cvtpk(P[B_+0], P[B_+1]), a1 = cvtpk(P[B_+2], P[B_+3]);                          \
        unsigned b0 = cvtpk(P[B_+4], P[B_+5]), b1 = cvtpk(P[B_+6], P[B_+7]);                                             \
        auto r0 = __builtin_amdgcn_permlane32_swap(a0, b0, false, false); auto r1 = __builtin_amdgcn_permlane32_swap(a1, b1, false, false); \
        v4u w = {r0[0], r1[0], r0[1], r1[1]}; OUT = *reinterpret_cast<bf16x8*>(&w); } while (0)
    PK4(p0, 0, pa0); PK4(p0, 8, pa1); PK4(p1, 0, pa2); PK4(p1, 8, pa3);
#undef PK4
}
template <int KB>
__device__ __forceinline__ void qkt(f32x16& p0, f32x16& p1, const char* K_lds, int r32, int hi, const bf16x8* qr) {
    p0 = f32x16{}; p1 = f32x16{};
    const char* kb[4];
#pragma unroll
    for (int dd = 0; dd < 4; ++dd) kb[dd] = K_lds + KB * SHM_K + KSWZ(r32, (dd * 16 + hi * 8) * 2);
#pragma unroll
    for (int d0 = 0; d0 < 8; ++d0) { const char* a = kb[d0 & 3] + (d0 >> 2) * 128;
        bf16x8 b0 = *reinterpret_cast<const bf16x8*>(a);
        bf16x8 b1 = *reinterpret_cast<const bf16x8*>(a + 32 * 256);
        p0 = __builtin_amdgcn_mfma_f32_32x32x16_bf16(b0, qr[d0], p0, 0, 0, 0);
        p1 = __builtin_amdgcn_mfma_f32_32x32x16_bf16(b1, qr[d0], p1, 0, 0, 0); }
}
template <int VB>
__device__ __forceinline__ void pv_tile(f32x16* o, int vb0, bf16x8 pa0, bf16x8 pa1, bf16x8 pa2, bf16x8 pa3) {
#define TRRD(dst, off) asm volatile("ds_read_b64_tr_b16 %0, %1 offset:%2" : "=&v"(dst) : "v"(vb0), "i"(off) : "memory")
#define PV_D0(d0) do { s16x4 l0, l1, l2, l3, h0, h1, h2, h3; constexpr int b_ = VB * SHM_V + v_rd_off(d0, 0, 0); \
        TRRD(l0, b_); TRRD(h0, b_ + 2048); TRRD(l1, b_ + 4096); TRRD(h1, b_ + 6144); TRRD(l2, b_ + 8192); TRRD(h2, b_ + 10240); TRRD(l3, b_ + 12288); TRRD(h3, b_ + 14336); \
        asm volatile("s_waitcnt lgkmcnt(0)" ::: "memory"); SBAR(); \
        o[d0] = __builtin_amdgcn_mfma_f32_32x32x16_bf16(pa0, (bf16x8){l0[0], l0[1], l0[2], l0[3], h0[0], h0[1], h0[2], h0[3]}, o[d0], 0, 0, 0);   \
        o[d0] = __builtin_amdgcn_mfma_f32_32x32x16_bf16(pa1, (bf16x8){l1[0], l1[1], l1[2], l1[3], h1[0], h1[1], h1[2], h1[3]}, o[d0], 0, 0, 0);   \
        o[d0] = __builtin_amdgcn_mfma_f32_32x32x16_bf16(pa2, (bf16x8){l2[0], l2[1], l2[2], l2[3], h2[0], h2[1], h2[2], h2[3]}, o[d0], 0, 0, 0);   \
        o[d0] = __builtin_amdgcn_mfma_f32_32x32x16_bf16(pa3, (bf16x8){l3[0], l3[1], l3[2], l3[3], h3[0], h3[1], h3[2], h3[3]}, o[d0], 0, 0, 0); } while (0)
    PV_D0(0); PV_D0(1); PV_D0(2); PV_D0(3);
#undef PV_D0
#undef TRRD
}
struct BlockRef { const bf16* Q; const bf16* K; const bf16* V; bf16* O; const u64* Mk; int P0; };
struct Seam { bf16x8 qr[8]; bf16x8 st_v0, st_v1, st_k0, st_k1; };
#define ROW(p, k0, rr) ((p) + (size_t)((k0) + (rr)) * D + sc)
#define VMW() asm volatile("s_waitcnt vmcnt(0)" ::: "memory")
#define VMWN(n) asm volatile("s_waitcnt vmcnt(%0)" :: "i"(n) : "memory")
#define SLOAD_H(Kp, Vp, k0) do { S.st_v0 = load8(ROW(Vp, k0, sr)); S.st_v1 = load8(ROW(Vp, k0, 32 + sr)); S.st_k0 = load8(ROW(Kp, k0, sr)); S.st_k1 = load8(ROW(Kp, k0, 32 + sr)); } while (0)
#define SWRITE_HK(bf) do { *(bf16x8*)(K_lds + (bf) * SHM_K + kws) = S.st_k0; *(bf16x8*)(K_lds + (bf) * SHM_K + kws + 32 * 256) = S.st_k1; } while (0)
#define SWRITE_HV(bf) do { *(bf16x8*)(V_lds + (bf) * SHM_V + vst0) = S.st_v0; *(bf16x8*)(V_lds + (bf) * SHM_V + vst1) = S.st_v1; } while (0)
#define SWRITE_H(bf) do { SWRITE_HV(bf); SWRITE_HK(bf); } while (0)
__device__ __forceinline__ void prime(const BlockRef& cur, char* lds, Seam& S) {
    const int tid = opaque_tid(), wid = __builtin_amdgcn_readfirstlane(tid >> 6), lane = tid & 63, r32 = lane & 31, hi = lane >> 5;
    const int sr = tid >> 4, sc = (tid & 15) * 8, kws = KSWZ(sr, sc * 2); char* K_lds = lds + 2 * SHM_V;
    for (int d0 = 0; d0 < 8; ++d0) S.qr[d0] = load8(cur.Q + (size_t)(wid * QBLK + r32) * D + d0 * 16 + hi * 8);
    SLOAD_H(cur.K, cur.V, 0); VMW(); SWRITE_HK(0);
    __syncthreads();
}
__device__ __forceinline__ void block(const BlockRef& cur, const BlockRef& nxt, char* lds, Seam& S) {
    const int tid = opaque_tid(), wid = __builtin_amdgcn_readfirstlane(tid >> 6), lane = tid & 63, r32 = lane & 31, hi = lane >> 5;
    const int NT = (cur.P0 + QB) / KVBLK;
    char* V_lds = lds; char* K_lds = lds + 2 * SHM_V;
    float* ws = (float*)(lds + 2 * SHM_V + 2 * SHM_K) + wid * 64; float* li_l = ws, * al_l = ws + 32;
    float m_reg = -1e30f, l_reg = 0; f32x16 o[4] = {};
    const int sr = tid >> 4, sc = (tid & 15) * 8, vst0 = v_st(sr, sc), vst1 = v_st(32 + sr, sc), kws = KSWZ(sr, sc * 2);
    const int vb0 = (int)(uintptr_t)V_lds + v_rd_base(lane);
    const bf16* Kh = cur.K; const bf16* Vh = cur.V;
    const u64* mk = cur.Mk + wid * QBLK + r32;
#define RESC(a) do { if (__any((a) < 1.f)) { if (hi == 0) al_l[r32] = (a); asm volatile("s_waitcnt lgkmcnt(0)" ::: "memory");              \
                     for (int d_ = 0; d_ < 4; ++d_) for (int r = 0; r < 16; ++r) o[d_][r] *= al_l[crow(r, hi)]; } } while (0)
#define KBASE(t) ((t) * KVBLK)
#define SEAM_K0() do { VMWN(8); SWRITE_HK(0); SBAR(); } while (0)
    f32x16 pA0, pA1, pB0, pB1; float mnA, mnB, alA, alB; bf16x8 pa0, pa1, pa2, pa3; u64 mw;
    SWRITE_HV(0); SBAR();
    mw = mk[0];
    if (NT > 1) SLOAD_H(Kh, Vh, KBASE(1));
    SBAR(); qkt<0>(pA0, pA1, K_lds, r32, hi, S.qr);
    mask_bits(pA0, pA1, mw, hi); partialSM(pA0, pA1, m_reg, mnA, alA);
    if (NT > 1) { VMW(); SWRITE_H(1); }
    __syncthreads();
#define HALF_STEP(PX0, PX1, mnX, alX, PY0, PY1, alY, t, KB, VB, SB) do {                                                      \
        SBAR(); mw = mk[(size_t)(t) * SEQ]; qkt<KB>(PX0, PX1, K_lds, r32, hi, S.qr);                                          \
        finishSM(PY0, PY1, alY, l_reg, pa0, pa1, pa2, pa3); SBAR();                                                           \
        if ((t) + 1 < NT) { SLOAD_H(Kh, Vh, KBASE((t) + 1)); SBAR(); }                                                        \
        pv_tile<VB>(o, vb0, pa0, pa1, pa2, pa3); mask_bits(PX0, PX1, mw, hi); partialSM(PX0, PX1, m_reg, mnX, alX);         \
        __syncthreads();                                                                                                      \
        if ((t) + 1 < NT) { VMW(); SWRITE_H(SB); }                                                                            \
        RESC(alX); __syncthreads(); } while (0)
    for (int t = 1; t + 1 < NT; t += 2) {
        HALF_STEP(pB0, pB1, mnB, alB, pA0, pA1, alA, t, 1, 0, 0);
        HALF_STEP(pA0, pA1, mnA, alA, pB0, pB1, alB, t + 1, 0, 1, 1);
    }
    mw = mk[(size_t)(NT - 1) * SEQ];
    SBAR(); qkt<1>(pB0, pB1, K_lds, r32, hi, S.qr); SBAR();
    SLOAD_H(nxt.K, nxt.V, 0); SBAR();
#pragma unroll
    for (int d0 = 0; d0 < 8; ++d0) S.qr[d0] = load8(nxt.Q + (size_t)(wid * QBLK + r32) * D + d0 * 16 + hi * 8);
    SBAR();
    finishSM(pA0, pA1, alA, l_reg, pa0, pa1, pa2, pa3); SBAR();
    pv_tile<0>(o, vb0, pa0, pa1, pa2, pa3);
    mask_bits(pB0, pB1, mw, hi); partialSM(pB0, pB1, m_reg, mnB, alB); __syncthreads(); RESC(alB);
    finishSM(pB0, pB1, alB, l_reg, pa0, pa1, pa2, pa3); SBAR(); pv_tile<1>(o, vb0, pa0, pa1, pa2, pa3);
    SBAR(); SEAM_K0();
    if (hi == 0) li_l[r32] = l_reg; asm volatile("s_waitcnt lgkmcnt(0)" ::: "memory");
    float rli[16];
#pragma unroll
    for (int r = 0; r < 16; ++r) rli[r] = __builtin_amdgcn_rcpf(li_l[crow(r, hi)]);
    bf16* Ow = cur.O + (size_t)(wid * QBLK) * LDO;
#pragma unroll
    for (int r = 0; r < 16; ++r) { const int orow = crow(r, hi);
#pragma unroll
        for (int d0 = 0; d0 < 4; ++d0) { const float v = o[d0][r] * rli[r];
            const float vn = __shfl_xor(v, 1);
            if ((r32 & 1) == 0) *(unsigned*)(Ow + (size_t)orow * LDO + d0 * 32 + r32) = cvtpk(v, vn); } }
    __syncthreads();
#undef RESC
#undef KBASE
#undef SEAM_K0
#undef HALF_STEP
}
#undef ROW
#undef VMW
#undef VMWN
#undef SLOAD_H
#undef SWRITE_HK
#undef SWRITE_HV
#undef SWRITE_H
#undef KSWZ
#undef SBAR
__device__ __forceinline__ BlockRef make_ref(unsigned char* wsp, float* outp, int bh, int qb) {
    unsigned char* Dp = wsp + WS_D; BlockRef r; const int b = bh >> 2, h = bh & 3; const size_t hb = (size_t)bh * SEQ;
    r.Q = (const bf16*)(Dp + D_AQ) + (hb + (size_t)qb * QB) * D; r.K = (const bf16*)(Dp + D_AK) + hb * D; r.V = (const bf16*)(Dp + D_AV) + hb * D;
    r.O = (bf16*)(wsp + WS_B) + ((size_t)b * SEQ + (size_t)qb * QB) * LDO + 512 + h * 128;
    r.Mk = (const u64*)((const unsigned char*)outp + O_MASK) + (size_t)b * 32 * SEQ + qb * QB; r.P0 = qb * QB;
    return r;
}
__device__ __forceinline__ void phase(unsigned char* lds_generic, const Args& a, int blk, int nblk) {
    char* lds = (char*)lds_generic; unsigned char* wsp = opq(a.ws); float* outp = opq(a.out);
    constexpr int NITEM = BATCH * 4 * 4;
    int L = blk; if (L >= NITEM) return;
    int pass = 0; BlockRef cur = make_ref(wsp, outp, L >> 2, L & 3);
    Seam S; prime(cur, lds, S);
    for (;;) {
        const bool more_pass = pass == 0, more_item = L + nblk < NITEM, last = !more_pass && !more_item;
        int Ln = L, passn = pass + 1; if (!more_pass) { passn = 0; Ln = more_item ? L + nblk : L; }
        const int x = Ln & 3; const BlockRef nxt = last ? cur : make_ref(wsp, outp, Ln >> 2, passn ? 7 - x : x);
        block(cur, nxt, lds, S);
        if (last) break;
        cur = nxt; pass = passn; L = Ln;
    }
}
}
__global__ void __launch_bounds__(256) k_convert_w(Args a) {
    __shared__ float scr[4][64 * 33];
    const int lane = threadIdx.x & 63, wave = threadIdx.x >> 6;
    convert_weights(a, a.layer, blockIdx.x * 4 + wave, gridDim.x * 4, (LAS float*)scr[wave], lane);
}
__global__ void __launch_bounds__(256) k_convert_x(Args a) { convert_x_and_rope(a, blockIdx.x * 256 + threadIdx.x, gridDim.x * 256); }
__global__ void __launch_bounds__(256) k_ln(Args a) {
    const int lane = threadIdx.x & 63, gw = blockIdx.x * 4 + (threadIdx.x >> 6), ngw = gridDim.x * 4;
    if (a.ph_lo == 0) ln_rows(a.out, (const float*)a.in[5] + a.layer * DM, (const float*)a.in[6] + a.layer * DM, a.out, (bf16*)(a.ws + WS_D + D_X1B), gw, ngw, lane);
    else if (a.layer + 1 < DEPTH) ln_rows(a.out, (const float*)a.in[9] + a.layer * DM, (const float*)a.in[10] + a.layer * DM, (float*)(a.ws + WS_C), (bf16*)(a.ws + WS_B), gw, ngw, lane);
    else ln_rows(a.out, (const float*)a.in[9] + a.layer * DM, (const float*)a.in[10] + a.layer * DM, a.out, nullptr, gw, ngw, lane);
}
__global__ void __launch_bounds__(512, 2) k_gemm(Args a) {
    extern __shared__ __attribute__((aligned(16))) unsigned char lds[];
    PG8_LAS unsigned char* L = (PG8_LAS unsigned char*)lds;
    unsigned char* ws = a.ws; unsigned char* D = ws + WS_D;
    const float* xres = a.layer == 0 ? (const float*)a.in[0] : (const float*)(ws + WS_C);
    pg8::StaticOrder S;
    if (a.ph_lo == 1) {
        pg8::Gemm g{(const bf16*)(ws + WS_B), (const bf16*)(ws + WS_WIN), M, IN_POS, DM}; S.init(M, IN_POS, gridDim.x, blockIdx.x);
        pg8::EpiProj E{D, (const float*)(ws + WS_R128), (const float*)(ws + WS_R64)};
        static_assert(pg8::EpiProj::O_RK == D_RK && pg8::EpiProj::O_RV == D_RV && pg8::EpiProj::O_RG == D_RG && pg8::EpiProj::O_AQ == D_AQ && pg8::EpiProj::O_AK == D_AK && pg8::EpiProj::O_AV == D_AV && pg8::EpiProj::O_IQ == D_IQ && pg8::EpiProj::O_IK == D_IK && pg8::EpiProj::O_IW == D_IW, "projection map");
        pg8::gemm_phase<pg8::EpiProj, pg8::StaticOrder, true, true>(L, g, S, E);
    } else if (a.ph_lo == 2) {
        pg8::Gemm g{(const bf16*)(ws + WS_B), (const bf16*)(ws + WS_WOUT), M, DM, DM}; S.init(M, DM, gridDim.x, blockIdx.x);
        pg8::EpiRes E{xres, a.out, DN_ALPHA};
        pg8::gemm_phase<pg8::EpiRes, pg8::StaticOrder, true, true>(L, g, S, E);
    } else if (a.ph_lo == 3) {
        pg8::Gemm g{(const bf16*)(D + D_X1B), (const bf16*)(ws + WS_WGU), M, 2 * FFN, DM}; S.init(M, 2 * FFN, gridDim.x, blockIdx.x);
        pg8::EpiSwiGLU E{(bf16*)(D + D_H)};
        pg8::gemm_phase<pg8::EpiSwiGLU, pg8::StaticOrder, true, true>(L, g, S, E);
    } else {
        pg8::Gemm g{(const bf16*)(D + D_H), (const bf16*)(ws + WS_WDN), M, DM, FFN}; S.init(M, DM, gridDim.x, blockIdx.x);
        pg8::EpiRes E{a.out, a.out, DN_ALPHA};
        pg8::gemm_phase<pg8::EpiRes, pg8::StaticOrder, true, true>(L, g, S, E);
    }
}

#ifndef FAST_RET
#define FAST_RET 1
#endif
#ifndef FAST_IDX
#define FAST_IDX 1
#endif
#ifndef FAST_ATT
#define FAST_ATT 1
#endif
constexpr int LDS_BYTES = 147456;
__global__ void __launch_bounds__(512, 2) k_fast(Args a) {
    extern __shared__ __attribute__((aligned(16))) unsigned char lds[];
    LAS unsigned char* L = (LAS unsigned char*)lds;
    if (a.ph_lo == 20) ret_state_phase(L, a, blockIdx.x, gridDim.x);
    else if (a.ph_lo == 21) idx_phase(L, a, blockIdx.x, gridDim.x);
    else if (a.ph_lo == 30) ret_out_phase(L, a, a.layer, blockIdx.x, gridDim.x);
    else att::phase(lds, a, blockIdx.x, gridDim.x);
}
__device__ __forceinline__ float block_sum128(float v, float* red) {
    v = wave_sum(v); __syncthreads(); if ((threadIdx.x & 63) == 0) red[threadIdx.x >> 6] = v; __syncthreads(); return red[0] + red[1];
}
__global__ void __launch_bounds__(128) k_naive_ret(Args a) {
    __shared__ float sq[128], sk[128], red[2];
    unsigned char* D = a.ws + WS_D; const bf16* rq = (const bf16*)(D + D_RQ); const bf16* rk = (const bf16*)(D + D_RK); const bf16* rv = (const bf16*)(D + D_RV); const bf16* rg = (const bf16*)(D + D_RG);
    bf16* mix = (bf16*)(a.ws + WS_B); const float* gain = (const float*)a.in[3] + a.layer * 512;
    const int b = blockIdx.x >> 2, h = blockIdx.x & 3, e = threadIdx.x;
    const float gamma = 1.0f - exp2f(-5.0f - (float)h); const float gn = gain[h * 128 + e];
    float S[128];
#pragma unroll
    for (int d = 0; d < 128; ++d) S[d] = 0.f;
    for (int t = 0; t < SEQ; ++t) {
        const size_t row = (size_t)b * SEQ + t;
        sq[e] = bf2f(rq[row * 512 + h * 128 + e]); sk[e] = bf2f(rk[row * 512 + h * 128 + e]); const float v = bf2f(rv[row * 512 + h * 128 + e]);
        __syncthreads();
        float o = 0.f;
#pragma unroll
        for (int d = 0; d < 128; ++d) { S[d] = gamma * S[d] + sk[d] * v; o += sq[d] * S[d]; }
        const float mean = block_sum128(o, red) * (1.f / 128.f); const float dv = o - mean;
        const float var = block_sum128(dv * dv, red) * (1.f / 128.f);
        const float y = dv * (1.0f / sqrtf(var + LN_EPS)) * gn * bf2f(rg[row * 512 + h * 128 + e]);
        mix[row * 1024 + h * 128 + e] = (bf16)f2bf(y);
        __syncthreads();
    }
}
__global__ void __launch_bounds__(256) k_naive_idx(Args a) {
    __shared__ float sq[512]; __shared__ float sw[8]; __shared__ unsigned keys[SEQ]; __shared__ int cnt[4];
    unsigned char* D = a.ws + WS_D; const bf16* iq = (const bf16*)(D + D_IQ); const bf16* ik = (const bf16*)(D + D_IK); const float* iw = (const float*)(D + D_IW);
    u64* mask = (u64*)((unsigned char*)a.out + O_MASK);
    const int t = blockIdx.x, b = blockIdx.y, tid = threadIdx.x, lane = tid & 63, wave = tid >> 6; const size_t row = (size_t)b * SEQ + t;
    sq[tid] = bf2f(iq[row * 512 + tid]); sq[tid + 256] = bf2f(iq[row * 512 + 256 + tid]); if (tid < 8) sw[tid] = iw[row * 8 + tid];
    __syncthreads();
    unsigned key[8];
#pragma unroll
    for (int k = 0; k < 8; ++k) { const int s = tid + 256 * k; key[k] = 0u;
        if (s <= t) { float kf[64]; const bf16* kr = ik + ((size_t)b * SEQ + s) * 64;
#pragma unroll
            for (int d = 0; d < 64; ++d) kf[d] = bf2f(kr[d]);
            float sc = 0.f;
#pragma unroll
            for (int h = 0; h < 8; ++h) { float dot = 0.f;
#pragma unroll
                for (int d = 0; d < 64; ++d) dot += sq[h * 64 + d] * kf[d];
                sc += sw[h] * fmaxf(dot, 0.f); }
            key[k] = okey(sc + 0.0f); }
        keys[s] = key[k]; }
    __syncthreads();
    bool sel[8];
    if (t < TOPK) {
#pragma unroll
        for (int k = 0; k < 8; ++k) sel[k] = (tid + 256 * k) <= t;
    } else {
        unsigned thr = 0u;
        for (int bit = 31; bit >= 0; --bit) { const unsigned cand = thr | (1u << bit); int c = 0;
#pragma unroll
            for (int k = 0; k < 8; ++k) c += __popcll(__ballot(key[k] >= cand));
            __syncthreads(); if (lane == 0) cnt[wave] = c; __syncthreads();
            if (cnt[0] + cnt[1] + cnt[2] + cnt[3] >= TOPK) thr = cand; }
        int c = 0;
#pragma unroll
        for (int k = 0; k < 8; ++k) c += __popcll(__ballot(key[k] > thr));
        __syncthreads(); if (lane == 0) cnt[wave] = c; __syncthreads();
        const int need = TOPK - (cnt[0] + cnt[1] + cnt[2] + cnt[3]);
#pragma unroll
        for (int k = 0; k < 8; ++k) { const int s = tid + 256 * k; sel[k] = key[k] > thr;
            if (key[k] == thr) { int rank = 0; for (int s2 = 0; s2 < s; ++s2) rank += (keys[s2] == thr) ? 1 : 0; sel[k] = rank < need; } }
    }
#pragma unroll
    for (int k = 0; k < 8; ++k) { const u64 w = __ballot(sel[k]); if (lane == 0) mask[((size_t)b * 32 + 4 * k + wave) * SEQ + t] = w; }
}
__global__ void __launch_bounds__(256) k_naive_att(Args a) {
    __shared__ float sp[4][SEQ]; __shared__ float sqv[4][128];
    unsigned char* D = a.ws + WS_D; const bf16* aq = (const bf16*)(D + D_AQ); const bf16* ak = (const bf16*)(D + D_AK); const bf16* av = (const bf16*)(D + D_AV);
    const u64* mask = (const u64*)((const unsigned char*)a.out + O_MASK); bf16* mix = (bf16*)(a.ws + WS_B);
    const int t = blockIdx.x, b = blockIdx.y, lane = threadIdx.x & 63, h = threadIdx.x >> 6; const size_t hb = ((size_t)b * 4 + h) * SEQ;
    sqv[h][lane] = bf2f(aq[(hb + t) * 128 + lane]); sqv[h][lane + 64] = bf2f(aq[(hb + t) * 128 + 64 + lane]);
    __syncthreads();
    float mx = -INFINITY;
    for (int j = 0; j <= t / 64; ++j) { const u64 w = mask[((size_t)b * 32 + j) * SEQ + t]; const int s = 64 * j + lane; float sc = -INFINITY;
        if ((w >> lane) & 1ull) { const bf16* kr = ak + (hb + s) * 128; float dot = 0.f;
            for (int d = 0; d < 128; ++d) dot += sqv[h][d] * bf2f(kr[d]);
            sc = dot * 0.08838834764831845f; }
        sp[h][s] = sc; mx = fmaxf(mx, sc); }
#pragma unroll
    for (int o = 1; o < 64; o <<= 1) mx = fmaxf(mx, __shfl_xor(mx, o));
    __syncthreads();
    float l = 0.f, o0 = 0.f, o1 = 0.f;
    for (int s = 0; s < 64 * (t / 64 + 1); ++s) { const float sc = sp[h][s]; if (sc == -INFINITY) continue;
        const float p = __expf(sc - mx); l += p; const bf16* vr = av + (hb + s) * 128; o0 += p * bf2f(vr[lane]); o1 += p * bf2f(vr[64 + lane]); }
    const float il = 1.0f / l; const size_t row = (size_t)b * SEQ + t;
    mix[row * 1024 + 512 + h * 128 + lane] = (bf16)f2bf(o0 * il); mix[row * 1024 + 512 + h * 128 + 64 + lane] = (bf16)f2bf(o1 * il);
}


typedef GAS unsigned gu32;
#define RLX_AGENT __ATOMIC_RELAXED, __HIP_MEMORY_SCOPE_AGENT
#define XB_TMO      128
#define XB_XCNT(j)  (256  + 64 * (j))
#define XB_XSUB(j)  (1280 + 64 * (j))
#define XB_XGEN(j)  (2304 + 64 * (j))
#define XB_TOP      3328
#define XB_TOPGEN   3392
#define XCD_BAR_WORDS 3456
#define XB_SPIN_CAP (1u << 18)

__device__ __forceinline__ unsigned xb_ld(unsigned* p)              { return __hip_atomic_load(p, __ATOMIC_RELAXED, __HIP_MEMORY_SCOPE_AGENT); }
__device__ __forceinline__ unsigned xb_add(unsigned* p, unsigned v) { return __hip_atomic_fetch_add(p, v, __ATOMIC_RELAXED, __HIP_MEMORY_SCOPE_AGENT); }
__device__ __forceinline__ unsigned xb_xcc_id() { return (unsigned)__builtin_amdgcn_s_getreg((3 << 11) | 20) & 0xFu; }
#define XB_SPIN(cond, bar) do { unsigned _sp = 0; while (cond) { __builtin_amdgcn_s_sleep(1); \
    if ((++_sp & 255u) == 0u) { if (xb_ld(&(bar)[XB_TMO])) break; if (_sp > XB_SPIN_CAP) { atomicAdd(&(bar)[XB_TMO], 1u); break; } } } } while (0)

struct XcdBarrier {
    unsigned* bar; unsigned x;
    volatile LAS unsigned* st;
};

__device__ __forceinline__ XcdBarrier xcd_barrier_post(unsigned* bar, volatile LAS unsigned* st) {
    XcdBarrier b; b.bar = bar; b.x = xb_xcc_id(); b.st = st;
    if (threadIdx.x == 0) (void)xb_add(&bar[XB_XCNT(b.x)], 1u);
    return b;
}
__device__ __forceinline__ void xcd_barrier_complete(unsigned* bar, unsigned x, unsigned& nloc, unsigned& nx) {
    const unsigned G = gridDim.x * gridDim.y * gridDim.z;
    unsigned sum, cnt, mine, sp = 0u;
    for (;;) {
        sum = 0u; cnt = 0u; mine = 0u;
#pragma unroll
        for (unsigned j = 0; j < 16; ++j) { const unsigned c = xb_ld(&bar[XB_XCNT(j)]); sum += c; cnt += (c > 0u) ? 1u : 0u; mine = (j == x) ? c : mine; }
        if (sum == G) break;
        __builtin_amdgcn_s_sleep(1);
        if ((++sp & 255u) == 0u) { if (xb_ld(&bar[XB_TMO])) break; if (sp > XB_SPIN_CAP) { atomicAdd(&bar[XB_TMO], 1u); break; } }
    }
    nloc = mine > 0u ? mine : 1u; nx = cnt > 0u ? cnt : 1u;
}

__device__ __forceinline__ void xcd_barrier(const XcdBarrier& b) {
    asm volatile("s_waitcnt vmcnt(0)" ::: "memory");
    __syncthreads();
    if (threadIdx.x == 0) {
        unsigned* bar = b.bar;
        __builtin_amdgcn_s_waitcnt(0);
        unsigned nloc = b.st[0], nx = b.st[1];
        if (nloc == 0u) { xcd_barrier_complete(bar, b.x, nloc, nx); b.st[0] = nloc; b.st[1] = nx; }
        const unsigned old = xb_add(&bar[XB_XSUB(b.x)], 1u);
        const unsigned gen = old / nloc;
        if (old + 1u == (gen + 1u) * nloc) {
            __builtin_amdgcn_fence(__ATOMIC_RELEASE, "agent");
            asm volatile("s_waitcnt vmcnt(0)" ::: "memory");
            const unsigned og = xb_add(&bar[XB_TOP], 1u);
            const unsigned tg = og / nx;
            if (og + 1u == (tg + 1u) * nx) xb_add(&bar[XB_TOPGEN], 1u);
            else XB_SPIN(xb_ld(&bar[XB_TOPGEN]) == tg, bar);
            __builtin_amdgcn_fence(__ATOMIC_ACQUIRE, "agent");
            xb_add(&bar[XB_XGEN(b.x)], 1u);
            asm volatile("s_waitcnt vmcnt(0)" ::: "memory");
        } else {
            XB_SPIN(xb_ld(&bar[XB_XGEN(b.x)]) == gen, bar);
            __builtin_amdgcn_fence(__ATOMIC_ACQUIRE, "agent");
            asm volatile("s_waitcnt vmcnt(0)" ::: "memory");
        }
    }
    __syncthreads();
}

#ifndef MEGA
#define MEGA 1
#endif
#ifndef PROBE_DUP
#define PROBE_DUP 0
#endif
#define REP(k) for (int rep_ = 0; rep_ < ((PROBE_DUP == (k)) ? 2 : 1); ++rep_)
__global__ void __launch_bounds__(512, 2) k_mega(const Args a) {
    extern __shared__ __attribute__((aligned(16))) unsigned char lds[];
    LAS unsigned char* L = (LAS unsigned char*)lds; PG8_LAS unsigned char* LG = (PG8_LAS unsigned char*)lds;
    cg::grid_group grid = cg::this_grid();
    const int blk = blockIdx.x, G = gridDim.x;
#define TIDS() const int tid = opaque_tid(), lane = tid & 63, wave = __builtin_amdgcn_readfirstlane(tid >> 6), gw = blk * 8 + wave, ngw = G * 8; (void)lane; (void)gw; (void)ngw
    {   volatile LAS unsigned* MISC = (volatile LAS unsigned*)(L + LDS_BYTES - 128);
        if (threadIdx.x < 32) MISC[threadIdx.x] = 0u;
        __syncthreads();
        (void)xcd_barrier_post((unsigned*)(a.ws + WS_CTL), MISC + 8); }
#define BAR() do { XcdBarrier bb_; bb_.bar = (unsigned*)(opq(a.ws) + WS_CTL); bb_.x = xb_xcc_id(); bb_.st = (volatile LAS unsigned*)(L + LDS_BYTES - 128) + 8; xcd_barrier(bb_); } while (0)
    REP(7) { TIDS(); convert_weights(a, 0, gw, ngw, (LAS float*)(L + wave * 8448), lane); convert_x_and_rope(a, blk * 512 + tid, G * 512); }
    grid.sync();
    BAR();
    for (int layer = 0; layer < DEPTH; ++layer) {
        REP(1) {
            unsigned char* ws = opq(a.ws); pg8::StaticOrder S;
            pg8::Gemm g{(const bf16*)(ws + WS_B), (const bf16*)(ws + WS_WIN), M, IN_POS, DM}; S.init(M, IN_POS, G, blk);
            pg8::EpiProj E{ws + WS_D, (const float*)(ws + WS_R128), (const float*)(ws + WS_R64)};
            pg8::gemm_phase<pg8::EpiProj, pg8::StaticOrder, true, true>(LG, g, S, E);
            BAR();
        }
        REP(2) { ret_state_phase(L, a, blk, G); idx_phase(L, a, blk, G); BAR(); }
#if PROBE_DUP == 8
        ret_state_phase(L, a, blk, G); BAR();
#endif
#if PROBE_DUP == 9
        idx_phase(L, a, blk, G); BAR();
#endif
        REP(3) { att::phase(lds, a, blk, G); ret_out_phase(L, a, layer, blk, G); BAR(); }
#if PROBE_DUP == 10
        att::phase(lds, a, blk, G); BAR();
#endif
#if PROBE_DUP == 11
        ret_out_phase(L, a, layer, blk, G); BAR();
#endif
        REP(4) {
            unsigned char* ws = opq(a.ws); pg8::StaticOrder S;
            const float* xres = layer == 0 ? (const float*)a.in[0] : (const float*)(ws + WS_C);
            pg8::Gemm g{(const bf16*)(ws + WS_B), (const bf16*)(ws + WS_WOUT), M, DM, DM}; S.init(M, DM, G, blk);
            pg8::EpiRes E{xres, opq(a.out), DN_ALPHA};
            pg8::gemm_phase<pg8::EpiRes, pg8::StaticOrder, true, true>(LG, g, S, E);
            BAR();
        }
        { TIDS(); float* o = opq(a.out); ln_rows(o, (const float*)a.in[5] + layer * DM, (const float*)a.in[6] + layer * DM, o, (bf16*)(opq(a.ws) + WS_D + D_X1B), gw, ngw, lane); }
        BAR();
        REP(5) {
            unsigned char* ws = opq(a.ws); pg8::StaticOrder S;
            pg8::Gemm g{(const bf16*)(ws + WS_D + D_X1B), (const bf16*)(ws + WS_WGU), M, 2 * FFN, DM}; S.init(M, 2 * FFN, G, blk);
            pg8::EpiSwiGLU E{(bf16*)(ws + WS_D + D_H)};
            pg8::gemm_phase<pg8::EpiSwiGLU, pg8::StaticOrder, true, true>(LG, g, S, E);
            BAR();
        }
        {
            unsigned char* ws = opq(a.ws); pg8::StaticOrder S; float* o = opq(a.out);
            pg8::Gemm g{(const bf16*)(ws + WS_D + D_H), (const bf16*)(ws + WS_WDN), M, DM, FFN}; S.init(M, DM, G, blk);
            pg8::EpiRes E{o, o, DN_ALPHA};
            pg8::gemm_phase<pg8::EpiRes, pg8::StaticOrder, true, true>(LG, g, S, E);
        }
        BAR();
        if (layer + 1 < DEPTH) {
            TIDS(); unsigned char* ws = opq(a.ws);
            ln_rows(opq(a.out), (const float*)a.in[9] + layer * DM, (const float*)a.in[10] + layer * DM, (float*)(ws + WS_C), (bf16*)(ws + WS_B), gw, ngw, lane);
            convert_weights(a, layer + 1, gw, ngw, (LAS float*)(L + wave * 8448), lane);
            BAR();
        } else {
            TIDS(); float* o = opq(a.out);
            ln_rows(o, (const float*)a.in[9] + layer * DM, (const float*)a.in[10] + layer * DM, o, nullptr, gw, ngw, lane);
        }
    }
#undef BAR
#undef TIDS
}

extern "C" void kernel_launch(void* const* d_in, const int* in_sizes, int n_in, void* d_out, int out_size, void* d_ws, size_t ws_size, hipStream_t stream) {
    static int init = 0;
    if (!init) { init = 1;
        if (n_in != 11 || out_size != M * DM || ws_size < WS_END) fprintf(stderr, "kernel_launch: unexpected shapes: n_in %d out %d ws %zu (need >= %zu)\n", n_in, out_size, ws_size, (size_t)WS_END);
        (void)hipFuncSetAttribute((const void*)k_gemm, hipFuncAttributeMaxDynamicSharedMemorySize, 131072);
        (void)hipFuncSetAttribute((const void*)k_fast, hipFuncAttributeMaxDynamicSharedMemorySize, LDS_BYTES);
    }
    Args a{}; for (int i = 0; i < 11; ++i) a.in[i] = d_in[i]; a.out = (float*)d_out; a.ws = (unsigned char*)d_ws;
#if MEGA
    static int grid = 0;
    if (!grid) {
        int dev = 0, cus = 0, per_cu = 0; (void)hipGetDevice(&dev); (void)hipDeviceGetAttribute(&cus, hipDeviceAttributeMultiprocessorCount, dev);
        (void)hipFuncSetAttribute((const void*)k_mega, hipFuncAttributeMaxDynamicSharedMemorySize, LDS_BYTES);
        if (hipOccupancyMaxActiveBlocksPerMultiprocessor(&per_cu, (const void*)k_mega, 512, LDS_BYTES) != hipSuccess || per_cu < 1) { fprintf(stderr, "kernel_launch: occupancy query says %d blocks per CU\n", per_cu); per_cu = 1; }
        grid = cus * 1;
        if (grid <= 0) grid = 256;
    }
    (void)hipMemsetAsync((unsigned char*)d_ws + WS_CTL, 0, 65536, stream);
    { void* args[] = {&a}; const hipError_t e = hipLaunchCooperativeKernel((void*)k_mega, dim3(grid), dim3(512), args, LDS_BYTES, stream);
      if (e != hipSuccess) fprintf(stderr, "kernel_launch: cooperative launch failed: %s (grid %d)\n", hipGetErrorString(e), grid); }
    return;
#endif
    hipLaunchKernelGGL(k_convert_x, dim3(2048), dim3(256), 0, stream, a);
    for (int layer = 0; layer < DEPTH; ++layer) {
        a.layer = layer; a.ph_lo = 0; a.ph_hi = 0;
        hipLaunchKernelGGL(k_convert_w, dim3(1024), dim3(256), 0, stream, a);
        a.ph_lo = 1; hipLaunchKernelGGL(k_gemm, dim3(256), dim3(512), 131072, stream, a);
#if FAST_RET
        a.ph_lo = 20; hipLaunchKernelGGL(k_fast, dim3(256), dim3(512), LDS_BYTES, stream, a);
        a.ph_lo = 30; hipLaunchKernelGGL(k_fast, dim3(256), dim3(512), LDS_BYTES, stream, a);
#else
        hipLaunchKernelGGL(k_naive_ret, dim3(64), dim3(128), 0, stream, a);
#endif
#if FAST_IDX
        a.ph_lo = 21; hipLaunchKernelGGL(k_fast, dim3(256), dim3(512), LDS_BYTES, stream, a);
#else
        hipLaunchKernelGGL(k_naive_idx, dim3(SEQ, BATCH), dim3(256), 0, stream, a);
#endif
#if FAST_ATT
        a.ph_lo = 31; hipLaunchKernelGGL(k_fast, dim3(256), dim3(512), LDS_BYTES, stream, a);
#else
        hipLaunchKernelGGL(k_naive_att, dim3(SEQ, BATCH), dim3(256), 0, stream, a);
#endif
        a.ph_lo = 2; hipLaunchKernelGGL(k_gemm, dim3(256), dim3(512), 131072, stream, a);
        a.ph_lo = 0; hipLaunchKernelGGL(k_ln, dim3(2048), dim3(256), 0, stream, a);
        a.ph_lo = 3; hipLaunchKernelGGL(k_gemm, dim3(256), dim3(512), 131072, stream, a);
        a.ph_lo = 4; hipLaunchKernelGGL(k_gemm, dim3(256), dim3(512), 131072, stream, a);
        a.ph_lo = 1; hipLaunchKernelGGL(k_ln, dim3(2048), dim3(256), 0, stream, a);
    }
}
```
